# Optimizing an MI355X kernel written in HIP

```python
import math
import numpy as np
import jax, jax.numpy as jnp
from jax import lax

D_MODEL = 1024
BATCH = 16
SEQ = 2048
DEPTH = 4

ROPE_THETA = 10000.0
NORM_EPS = 1e-6
Q_BLOCK = 128

A_HEADS = 8
A_NOPE = 64
A_ROPE = 32
A_KV_RANK = 128
A_V_DIM = 64
A_SCALE = (A_NOPE + A_ROPE) ** -0.5
IDX_HEADS = 8
IDX_DIM = 64
TOPK_MAX = 256

B_HEADS = 4
B_QK_DIM = 64
B_V_DIM = 2 * B_QK_DIM

C_HEADS = 16
C_GROUPS = 4
C_HPG = C_HEADS // C_GROUPS
C_DIM = 64
CMP_LEN = 32
CMP_STRIDE = 16
CMP_HIDDEN = 128
SEL_BLOCK = 64
SEL_TOPN = 16
WINDOW = 512
C_Q_BLOCK = 16

D_FF = -(-8 * D_MODEL // (3 * 256)) * 256

EVEN_SPLITS = [A_HEADS * A_NOPE, A_HEADS * A_ROPE, A_KV_RANK, A_ROPE, IDX_HEADS * IDX_DIM, IDX_DIM, IDX_HEADS,
               B_HEADS * 2 * B_QK_DIM, B_HEADS * 2 * B_QK_DIM, B_HEADS * B_V_DIM]
EVEN_IN = sum(EVEN_SPLITS)
ODD_SPLITS = [C_HEADS * C_DIM] + [C_GROUPS * C_DIM] * 6 + [C_HEADS * 3]
ODD_IN = sum(ODD_SPLITS)

kernel_name = 'hybrid_dsa_diff_nsa_trunk'


def rmsnorm(x, g):
    xf = x.astype(jnp.float32)
    y = xf * lax.rsqrt(jnp.mean(xf * xf, axis=-1, keepdims=True) + NORM_EPS)
    return (y * g.astype(jnp.float32)).astype(x.dtype)


def rope(x, pos):
    d = x.shape[-1]
    inv = ROPE_THETA ** (-jnp.arange(0, d, 2, dtype=jnp.float32) / d)
    ang = pos.astype(jnp.float32)[:, None] * inv[None, :]
    shape = (x.shape[1],) + (1,) * (x.ndim - 3) + (d // 2,)
    cos = jnp.cos(ang).reshape(shape)
    sin = jnp.sin(ang).reshape(shape)
    xf = x.astype(jnp.float32)
    x1, x2 = xf[..., :d // 2], xf[..., d // 2:]
    return jnp.concatenate([x1 * cos - x2 * sin, x2 * cos + x1 * sin], axis=-1).astype(x.dtype)


def safe_softmax(s, mask):
    s = jnp.where(mask, s, -jnp.inf)
    m = jnp.max(s, axis=-1, keepdims=True)
    m = jnp.where(jnp.isfinite(m), m, 0.0)
    e = jnp.exp(s - m)
    den = jnp.sum(e, axis=-1, keepdims=True)
    return e / jnp.where(den > 0, den, 1.0)


def split_cols(y, sizes):
    return jnp.split(y, np.cumsum(sizes)[:-1].tolist(), axis=-1)


def qslice(a, i, qb):
    return lax.dynamic_slice_in_dim(a, i * qb, qb, axis=1)


def map_blocks(fn, n_blocks):
    out = lax.map(fn, jnp.arange(n_blocks, dtype=jnp.int32))
    nb, b, qb = out.shape[:3]
    return jnp.moveaxis(out, 0, 1).reshape((b, nb * qb) + out.shape[3:])


def dsa_mixer(q_nope, q_rope, c_kv, k_rope, iq, ik, iw, kv_gain, w_uk, w_uv, pos):
    B, T = c_kv.shape[:2]
    q_nope = q_nope.reshape(B, T, A_HEADS, A_NOPE)
    q_rope = rope(q_rope.reshape(B, T, A_HEADS, A_ROPE), pos)
    c_kv = rmsnorm(c_kv, kv_gain)
    k_rope = rope(k_rope, pos)
    q_lat = jnp.einsum('bthd,hdc->bthc', q_nope, w_uk)
    qc = jnp.concatenate([q_lat, q_rope], axis=-1)
    kc = jnp.concatenate([c_kv, k_rope], axis=-1)
    iq = rope(iq.reshape(B, T, IDX_HEADS, IDX_DIM), pos)
    ik = rope(ik, pos)
    iw = iw * IDX_HEADS ** -0.5
    k_sel = min(TOPK_MAX, T // 4)

    def block(i):
        t = i * Q_BLOCK + jnp.arange(Q_BLOCK, dtype=jnp.int32)
        rel = jax.nn.relu(jnp.einsum('bqhd,bsd->bqhs', qslice(iq, i, Q_BLOCK), ik).astype(jnp.float32) * IDX_DIM ** -0.5)
        score = jnp.einsum('bqhs,bqh->bqs', rel, qslice(iw, i, Q_BLOCK).astype(jnp.float32))
        causal = pos[None, :] <= t[:, None]
        score = jnp.where(causal[None], score, -jnp.inf)
        _, idx = lax.top_k(score, k_sel)
        kg = jax.vmap(lambda k, j: k[j])(kc, idx)
        s = jnp.einsum('bqhc,bqkc->bqhk', qslice(qc, i, Q_BLOCK), kg).astype(jnp.float32) * A_SCALE
        valid = (idx <= t[None, :, None])[:, :, None, :]
        p = safe_softmax(s, valid)
        return jnp.einsum('bqhk,bqkc->bqhc', p.astype(kg.dtype), kg[..., :A_KV_RANK])

    o_lat = map_blocks(block, T // Q_BLOCK)
    o = jnp.einsum('bthc,hcd->bthd', o_lat, w_uv)
    return o.reshape(B, T, A_HEADS * A_V_DIM)


def diff_mixer(q, k, v, lam, subln_gain, lam_init, pos):
    B, T = q.shape[:2]
    q = rope(q.reshape(B, T, B_HEADS * 2, B_QK_DIM), pos).reshape(B, T, B_HEADS, 2, B_QK_DIM)
    k = rope(k.reshape(B, T, B_HEADS * 2, B_QK_DIM), pos).reshape(B, T, B_HEADS, 2, B_QK_DIM)
    v = v.reshape(B, T, B_HEADS, B_V_DIM)
    lf = lam.astype(jnp.float32)
    lam_full = jnp.exp(jnp.sum(lf[0] * lf[1])) - jnp.exp(jnp.sum(lf[2] * lf[3])) + lam_init

    def block(i):
        t = i * Q_BLOCK + jnp.arange(Q_BLOCK, dtype=jnp.int32)
        s = jnp.einsum('bqhmd,bshmd->bhmqs', qslice(q, i, Q_BLOCK), k).astype(jnp.float32) * B_QK_DIM ** -0.5
        causal = pos[None, :] <= t[:, None]
        p = safe_softmax(s, causal)
        a = p[:, :, 0] - lam_full * p[:, :, 1]
        return jnp.einsum('bhqs,bshe->bqhe', a.astype(v.dtype), v)

    o = map_blocks(block, T // Q_BLOCK)
    o = rmsnorm(o, subln_gain) * (1.0 - lam_init)
    return o.reshape(B, T, B_HEADS * B_V_DIM)


def compress(x, pe, w1, w2):
    B, T, G, d = x.shape
    chunks = x.reshape(B, T // CMP_STRIDE, CMP_STRIDE, G, d)
    blocks = jnp.concatenate([chunks[:, :-1], chunks[:, 1:]], axis=2) + pe[None, None, :, None, :]
    flat = blocks.transpose(0, 1, 3, 2, 4).reshape(B, -1, G, CMP_LEN * d)
    return jnp.einsum('bngf,fe->bnge', jax.nn.gelu(flat @ w1), w2)


def nsa_mixer(q, kc_raw, vc_raw, ks, vs, kw, vw, gates, pe, w1, w2, pos):
    B, T = q.shape[:2]
    kv = lambda a: a.reshape(B, T, C_GROUPS, C_DIM)
    q = rope(q.reshape(B, T, C_HEADS, C_DIM), pos).reshape(B, T, C_GROUPS, C_HPG, C_DIM)
    k_cmp = compress(rope(kv(kc_raw), pos), pe[0], w1[0], w2[0])
    v_cmp = compress(kv(vc_raw), pe[1], w1[1], w2[1])
    k_slc, v_slc = rope(kv(ks), pos), kv(vs)
    k_win, v_win = rope(kv(kw), pos), kv(vw)
    gates = jax.nn.sigmoid(gates.astype(jnp.float32)).reshape(B, T, C_GROUPS, C_HPG, 3).astype(q.dtype)
    n_cmp = T // CMP_STRIDE - 1
    n_blk = T // SEL_BLOCK
    top_n = min(SEL_TOPN, n_blk)
    cmp_end = jnp.arange(n_cmp, dtype=jnp.int32) * CMP_STRIDE + CMP_LEN - 1
    cs = np.arange(n_cmp) * CMP_STRIDE
    ss = np.arange(n_blk) * SEL_BLOCK
    overlap = jnp.asarray(((cs[:, None] < ss[None, :] + SEL_BLOCK) & (cs[:, None] + CMP_LEN > ss[None, :])).astype(np.float32))
    k_blocks = k_slc.reshape(B, n_blk, SEL_BLOCK, C_GROUPS, C_DIM).transpose(0, 3, 1, 2, 4)
    v_blocks = v_slc.reshape(B, n_blk, SEL_BLOCK, C_GROUPS, C_DIM).transpose(0, 3, 1, 2, 4)
    k_pad = jnp.pad(k_win, ((0, 0), (WINDOW, 0), (0, 0), (0, 0)))
    v_pad = jnp.pad(v_win, ((0, 0), (WINDOW, 0), (0, 0), (0, 0)))
    blk_ids = jnp.arange(n_blk, dtype=jnp.int32)
    scale = C_DIM ** -0.5
    gather = jax.vmap(jax.vmap(lambda a, j: a[j]))

    def block(i):
        t = i * C_Q_BLOCK + jnp.arange(C_Q_BLOCK, dtype=jnp.int32)
        qb = qslice(q, i, C_Q_BLOCK)
        s = jnp.einsum('bqghd,bngd->bqghn', qb, k_cmp).astype(jnp.float32) * scale
        p_cmp = safe_softmax(s, (cmp_end[None, :] <= t[:, None])[:, None, None, :])
        o_cmp = jnp.einsum('bqghn,bngd->bqghd', p_cmp.astype(v_cmp.dtype), v_cmp)
        imp = jnp.einsum('bqghn,nj->bqgj', p_cmp, overlap)
        cur = t // SEL_BLOCK
        forced = (blk_ids[None, :] == 0) | (blk_ids[None, :] == cur[:, None]) | (blk_ids[None, :] == cur[:, None] - 1)
        admissible = blk_ids[None, :] * SEL_BLOCK <= t[:, None]
        imp = jnp.where(forced[:, None, :], jnp.inf, imp)
        imp = jnp.where(admissible[:, None, :], imp, -jnp.inf)
        _, sel = lax.top_k(imp, top_n)
        sel = sel.transpose(0, 2, 1, 3)
        kg = gather(k_blocks, sel)
        vg = gather(v_blocks, sel)
        s = jnp.einsum('bqghd,bgqnld->bqghnl', qb, kg).astype(jnp.float32) * scale
        tok = sel[..., None] * SEL_BLOCK + jnp.arange(SEL_BLOCK, dtype=jnp.int32)
        m_slc = (tok <= t[None, None, :, None, None]).transpose(0, 2, 1, 3, 4)
        m_slc = m_slc.reshape(B, C_Q_BLOCK, C_GROUPS, 1, top_n * SEL_BLOCK)
        p = safe_softmax(s.reshape(B, C_Q_BLOCK, C_GROUPS, C_HPG, top_n * SEL_BLOCK), m_slc)
        p = p.reshape(B, C_Q_BLOCK, C_GROUPS, C_HPG, top_n, SEL_BLOCK)
        o_slc = jnp.einsum('bqghnl,bgqnld->bqghd', p.astype(vg.dtype), vg)
        kwb = lax.dynamic_slice_in_dim(k_pad, i * C_Q_BLOCK, WINDOW + C_Q_BLOCK, axis=1)
        vwb = lax.dynamic_slice_in_dim(v_pad, i * C_Q_BLOCK, WINDOW + C_Q_BLOCK, axis=1)
        kpos = i * C_Q_BLOCK - WINDOW + jnp.arange(WINDOW + C_Q_BLOCK, dtype=jnp.int32)
        dist = t[:, None] - kpos[None, :]
        m_win = ((dist >= 0) & (dist < WINDOW) & (kpos[None, :] >= 0))[:, None, None, :]
        s = jnp.einsum('bqghd,bsgd->bqghs', qb, kwb).astype(jnp.float32) * scale
        p = safe_softmax(s, m_win)
        o_win = jnp.einsum('bqghs,bsgd->bqghd', p.astype(vwb.dtype), vwb)
        g = qslice(gates, i, C_Q_BLOCK)
        return g[..., 0:1] * o_cmp + g[..., 1:2] * o_slc + g[..., 2:3] * o_win

    o = map_blocks(block, T // C_Q_BLOCK)
    return o.reshape(B, T, C_HEADS * C_DIM)


def swiglu(h, w_gate, w_up, w_down):
    return (jax.nn.silu(h @ w_gate) * (h @ w_up)) @ w_down


def _w(key, shape, fan_in, gain=1.0):
    return jax.random.normal(key, shape, jnp.float32) * (gain * fan_in ** -0.5)


def _gain(key, shape):
    return 1.0 + 0.02 * jax.random.normal(key, shape, jnp.float32)


def setup_inputs(seed: int = 0) -> dict:
    key = jax.random.key(seed)
    k = jax.random.split(key, 19)
    n_even = (DEPTH + 1) // 2
    n_odd = DEPTH // 2
    out_gain = (2 * DEPTH) ** -0.5
    return {
        'x': jax.random.normal(k[0], (BATCH, SEQ, D_MODEL), jnp.float32),
        'norm_mix': _gain(k[1], (DEPTH, D_MODEL)),
        'norm_ffn': _gain(k[2], (DEPTH, D_MODEL)),
        'norm_final': _gain(k[3], (D_MODEL,)),
        'ev_w_in': _w(k[4], (n_even, D_MODEL, EVEN_IN), D_MODEL),
        'ev_kv_gain': _gain(k[5], (n_even, A_KV_RANK)),
        'ev_w_uk': _w(k[6], (n_even, A_HEADS, A_NOPE, A_KV_RANK), A_KV_RANK),
        'ev_w_uv': _w(k[7], (n_even, A_HEADS, A_KV_RANK, A_V_DIM), A_KV_RANK),
        'ev_lambda': 0.1 * jax.random.normal(k[8], (n_even, 4, B_QK_DIM), jnp.float32),
        'ev_subln': _gain(k[9], (n_even, B_V_DIM)),
        'ev_w_out': _w(k[10], (n_even, D_MODEL, D_MODEL), D_MODEL, out_gain),
        'od_w_in': _w(k[11], (n_odd, D_MODEL, ODD_IN), D_MODEL),
        'od_cmp_pe': 0.1 * jax.random.normal(k[12], (n_odd, 2, CMP_LEN, C_DIM), jnp.float32),
        'od_cmp_w1': _w(k[13], (n_odd, 2, CMP_LEN * C_DIM, CMP_HIDDEN), CMP_LEN * C_DIM),
        'od_cmp_w2': _w(k[14], (n_odd, 2, CMP_HIDDEN, C_DIM), CMP_HIDDEN),
        'od_w_out': _w(k[15], (n_odd, D_MODEL, D_MODEL), D_MODEL, out_gain),
        'ffn_w_gate': _w(k[16], (DEPTH, D_MODEL, D_FF), D_MODEL),
        'ffn_w_up': _w(k[17], (DEPTH, D_MODEL, D_FF), D_MODEL),
        'ffn_w_down': _w(k[18], (DEPTH, D_FF, D_MODEL), D_FF, out_gain),
    }


def reference(x, norm_mix, norm_ffn, norm_final,
              ev_w_in, ev_kv_gain, ev_w_uk, ev_w_uv, ev_lambda, ev_subln, ev_w_out,
              od_w_in, od_cmp_pe, od_cmp_w1, od_cmp_w2, od_w_out,
              ffn_w_gate, ffn_w_up, ffn_w_down):
    pos = jnp.arange(x.shape[1], dtype=jnp.int32)
    for layer in range(DEPTH):
        j = layer // 2
        h = rmsnorm(x, norm_mix[layer])
        if layer % 2 == 0:
            y = h @ ev_w_in[j]
            qa_nope, qa_rope, c_kv, ka_rope, iq, ik, iw, qb, kb, vb = split_cols(y, EVEN_SPLITS)
            o_a = dsa_mixer(qa_nope, qa_rope, c_kv, ka_rope, iq, ik, iw, ev_kv_gain[j], ev_w_uk[j], ev_w_uv[j], pos)
            lam_init = 0.8 - 0.6 * math.exp(-0.3 * layer)
            o_b = diff_mixer(qb, kb, vb, ev_lambda[j], ev_subln[j], lam_init, pos)
            mix = jnp.concatenate([o_a, o_b], axis=-1) @ ev_w_out[j]
        else:
            y = h @ od_w_in[j]
            qc, kc_raw, vc_raw, ks, vs, kw, vw, gc = split_cols(y, ODD_SPLITS)
            o_c = nsa_mixer(qc, kc_raw, vc_raw, ks, vs, kw, vw, gc, od_cmp_pe[j], od_cmp_w1[j], od_cmp_w2[j], pos)
            mix = o_c @ od_w_out[j]
        x = x + mix
        x = x + swiglu(rmsnorm(x, norm_ffn[layer]), ffn_w_gate[layer], ffn_w_up[layer], ffn_w_down[layer])
    return rmsnorm(x, norm_final)
```

```cpp
#include <hip/hip_runtime.h>
#include <hip/hip_cooperative_groups.h>
#include <stdint.h>
#include <stdio.h>
namespace cg = cooperative_groups;

#ifndef EN_EVEN
#define EN_EVEN 1
#endif
#ifndef EN_ODD
#define EN_ODD 1
#endif
#ifndef EN_DSA
#define EN_DSA 1
#endif
#ifndef EN_DIFF
#define EN_DIFF 1
#endif
#ifndef EN_FFN
#define EN_FFN 1
#endif
#ifndef REP_ATT
#define REP_ATT 1
#endif
#ifndef REP_GEMM
#define REP_GEMM 1
#endif
#ifndef REP_IDX
#define REP_IDX 1
#endif
#ifndef REP_DIFF
#define REP_DIFF 1
#endif
#ifndef REP_PRO
#define REP_PRO 1
#endif

#define DI __device__ __forceinline__
typedef unsigned short bf16_t;
typedef short bf16x8 __attribute__((ext_vector_type(8)));
typedef float f32x2 __attribute__((ext_vector_type(2)));
typedef float f32x4 __attribute__((ext_vector_type(4)));
typedef float f32x16 __attribute__((ext_vector_type(16)));
typedef __bf16 bf16x2_t __attribute__((ext_vector_type(2)));
typedef unsigned u32x2 __attribute__((ext_vector_type(2)));
typedef unsigned u32x4 __attribute__((ext_vector_type(4)));
typedef unsigned long long u64;

constexpr int NTOK = 32768, T = 2048, NB = 16, DM = 1024, DFF = 2816;
constexpr int LDE = 3072, LDO = 2688, NODD = 2816, NTHR = 512;
constexpr int E_QNOPE = 0, E_QROPE = 512, E_CKV = 768, E_KROPE = 896, E_IQ = 928, E_IK = 1440, E_QB = 1504, E_KB = 2016, E_VB = 2528, E_IW = 3040;
constexpr int O_Q = 0, O_KC = 1024, O_VC = 1280, O_KS = 1536, O_VS = 1792, O_KW = 2048, O_VW = 2304, O_G = 2560;
constexpr float LOG2E = 1.4426950408889634f;
constexpr float NEG_INF = -__builtin_huge_valf();

struct Params {
  const float *x, *norm_mix, *norm_ffn, *norm_final, *ev_w_in, *ev_kv_gain, *ev_w_uk, *ev_w_uv, *ev_lambda, *ev_subln, *ev_w_out,
      *od_w_in, *od_cmp_pe, *od_cmp_w1, *od_cmp_w2, *od_w_out, *ffn_w_gate, *ffn_w_up, *ffn_w_down;
  float* out;
  bf16_t *WE, *WEO, *WO, *WOO, *WGU, *WD, *WC1, *WC2, *WUVP, *WUKT;
  float *CBP, *CB, *cos64, *sin64, *cos32, *sin32;
  bf16_t *H, *Y, *O;
  u64* SEL;
  float *IW, *GATES;
  float* SCR;
  bf16_t *CH, *KCMP, *VCMP;
  unsigned* BAR;
};

DI int otid() { int t = threadIdx.x; asm volatile("" : "+v"(t)); return t; }
DI int obid() { int b = blockIdx.x; asm volatile("" : "+s"(b)); return b; }
DI unsigned pk2(float a, float b) { f32x2 v = {a, b}; bf16x2_t r = __builtin_convertvector(v, bf16x2_t); return __builtin_bit_cast(unsigned, r); }
DI float bf2f(bf16_t v) { return __uint_as_float(((unsigned)v) << 16); }
DI float ex2(float x) { return __builtin_amdgcn_exp2f(x); }
DI f32x4 mfma16(bf16x8 a, bf16x8 b, f32x4 c) { return __builtin_amdgcn_mfma_f32_16x16x32_bf16(a, b, c, 0, 0, 0); }
DI f32x16 mfma32(bf16x8 a, bf16x8 b, f32x16 c) { return __builtin_amdgcn_mfma_f32_32x32x16_bf16(a, b, c, 0, 0, 0); }

DI void tconv(float* tile, const float* src, int sld, int c0, int n, int K, bf16_t* dst, int dld, int r0, int mode, int& base) {
  const int tid = otid(), lane = tid & 63, ch = lane & 7, c4i = lane >> 3;
  const int GW = gridDim.x * (NTHR / 64);
  const int ncg = (n + 31) >> 5, items = ncg * (K >> 6), n4 = n >> 2;
  int start = obid() * (NTHR / 64) + (tid >> 6) - base; if (start < 0) start += GW;
  for (int it = start; it < items; it += GW) {
    const int cg = it % ncg, ks = it / ncg, c4 = cg * 8 + c4i;
    if (c4 < n4) {
      const int cc0 = c4 * 4;
      const float* sp = src + (long)(ks * 64 + ch * 8) * sld + c0 + cc0;
      f32x4 v[8];
#pragma unroll
      for (int kk = 0; kk < 8; ++kk) v[kk] = *(const f32x4*)(sp + (long)kk * sld);
#pragma unroll
      for (int q = 0; q < 4; ++q) {
        const int cc = cc0 + q; int row = cc;
        if (mode == 1) row = (cc >> 4) * 32 + (cc & 15);
        else if (mode == 2) row = (cc >> 4) * 32 + 16 + (cc & 15);
        else if (mode == 3) row = (cc & ~63) + ((cc & 31) >> 4) * 32 + ((cc >> 5) & 1) * 16 + (cc & 15);
        u32x4 w; w[0] = pk2(v[0][q], v[1][q]); w[1] = pk2(v[2][q], v[3][q]); w[2] = pk2(v[4][q], v[5][q]); w[3] = pk2(v[6][q], v[7][q]);
        *(u32x4*)(dst + (long)(r0 + row) * dld + ks * 64 + ch * 8) = w;
      }
    }
  }
  base = (base + items) % GW;
}

DI void prologue(char* smem, const Params& p) {
  float* tile = (float*)smem;
  const int tid = otid(), G = gridDim.x, bid = obid();
  int base = 0;
  for (int l = 0; l < 4; ++l) {
    tconv(tile, p.ffn_w_gate + (long)l * DM * DFF, DFF, 0, DFF, DM, p.WGU + (long)l * 2 * DFF * DM, DM, 0, 1, base);
    tconv(tile, p.ffn_w_up + (long)l * DM * DFF, DFF, 0, DFF, DM, p.WGU + (long)l * 2 * DFF * DM, DM, 0, 2, base);
    tconv(tile, p.ffn_w_down + (long)l * DFF * DM, DM, 0, DM, DFF, p.WD + (long)l * DM * DFF, DFF, 0, 0, base);
  }
  for (int j = 0; j < 2; ++j) {
    const float* src = p.ev_w_in + (long)j * DM * 3048;
    bf16_t* dst = p.WE + (long)j * LDE * DM;
    tconv(tile, src, 3048, 0, 928, DM, dst, DM, 0, 0, base);
    tconv(tile, src, 3048, 928, 576, DM, dst, DM, E_IQ, 3, base);
    tconv(tile, src, 3048, 1504, 8, DM, dst, DM, E_IW, 0, base);
    tconv(tile, src, 3048, 1512, 1024, DM, dst, DM, E_QB, 3, base);
    tconv(tile, src, 3048, 2536, 512, DM, dst, DM, E_VB, 0, base);
    tconv(tile, p.ev_w_out + (long)j * DM * DM, DM, 0, DM, DM, p.WEO + (long)j * DM * DM, DM, 0, 0, base);
    {
      const float* so = p.od_w_in + (long)j * DM * 2608; bf16_t* dd = p.WO + (long)j * NODD * DM;
      tconv(tile, so, 2608, 0, 1280, DM, dd, DM, 0, 3, base);
      tconv(tile, so, 2608, 1280, 256, DM, dd, DM, 1280, 0, base);
      tconv(tile, so, 2608, 1536, 256, DM, dd, DM, 1536, 3, base);
      tconv(tile, so, 2608, 1792, 256, DM, dd, DM, 1792, 0, base);
      tconv(tile, so, 2608, 2048, 256, DM, dd, DM, 2048, 3, base);
      tconv(tile, so, 2608, 2304, 304, DM, dd, DM, 2304, 0, base);
    }
    tconv(tile, p.od_w_out + (long)j * DM * DM, DM, 0, DM, DM, p.WOO + (long)j * DM * DM, DM, 0, 0, base);
    for (int kv = 0; kv < 2; ++kv) {
      tconv(tile, p.od_cmp_w1 + (long)(j * 2 + kv) * 2048 * 128, 128, 0, 128, 2048, p.WC1 + (long)(j * 2 + kv) * 128 * 2048, 2048, 0, 0, base);
      tconv(tile, p.od_cmp_w2 + (long)(j * 2 + kv) * 128 * 64, 64, 0, 64, 128, p.WC2 + (long)(j * 2 + kv) * 128 * 128, 128, 0, 0, base);
    }
  }
  for (int idx = bid * NTHR + tid; idx < 2 * 8 * 128 * 64; idx += G * NTHR) {
    const int d = idx & 63, c = (idx >> 6) & 127, jh = idx >> 13;
    p.WUKT[idx] = (bf16_t)(pk2(p.ev_w_uk[((long)jh * 64 + d) * 128 + c], 0.f) & 0xffff);
  }
  for (int idx = bid * NTHR + tid; idx < 2 * 8 * 64 * 128; idx += G * NTHR) {
    const int pp = idx & 127, d = (idx >> 7) & 63, jh = idx >> 13;
    const int s = pp >> 4, hh = (pp >> 3) & 1, jj = pp & 7, c = 16 * s + 8 * (jj >> 2) + 4 * hh + (jj & 3);
    p.WUVP[idx] = (bf16_t)(pk2(p.ev_w_uv[((long)jh * 128 + c) * 64 + d], 0.f) & 0xffff);
  }
  for (int idx = bid * NTHR + tid; idx < T * 48; idx += G * NTHR) {
    const int pos = idx / 48, e = idx % 48;
    if (e < 32) {
      const float inv = (float)pow(10000.0, -(double)(2 * e) / 64.0);
      const float ang = (float)pos * inv;
      p.cos64[pos * 32 + e] = (float)cos((double)ang); p.sin64[pos * 32 + e] = (float)sin((double)ang);
    } else {
      const int i = e - 32;
      const float inv = (float)pow(10000.0, -(double)(2 * i) / 32.0);
      const float ang = (float)pos * inv;
      p.cos32[pos * 16 + i] = (float)cos((double)ang); p.sin32[pos * 16 + i] = (float)sin((double)ang);
    }
  }
  for (int it = bid; it < 4 * 16; it += G) {
    const int jk = it >> 4, ch = it & 15, c = tid & 127, q = tid >> 7;
    const float* pe = p.od_cmp_pe + (long)jk * 2048 + ch * 128 + q * 32;
    const float* w1 = p.od_cmp_w1 + ((long)jk * 2048 + ch * 128 + q * 32) * 128 + c;
    float s = 0.f;
#pragma unroll 8
    for (int f = 0; f < 32; ++f) s += pe[f] * w1[(long)f * 128];
    p.CBP[(jk * 64 + ch * 4 + q) * 128 + c] = s;
  }
}

template <bool TO_BF16>
DI void rmsnorm_phase(const Params& p, const float* xin, const float* gain, bf16_t* hout, float* fout) {
  const int lane = otid() & 63, wid = otid() >> 6;
  const int gw = obid() * 8 + wid, nw = gridDim.x * 8;
  f32x4 g[4];
#pragma unroll
  for (int i = 0; i < 4; ++i) g[i] = *(const f32x4*)(gain + i * 256 + lane * 4);
  for (int row = gw; row < NTOK; row += nw) {
    const float* xr = xin + (long)row * DM;
    f32x4 v[4]; float ss = 0.f;
#pragma unroll
    for (int i = 0; i < 4; ++i) { v[i] = *(const f32x4*)(xr + i * 256 + lane * 4); ss += v[i][0] * v[i][0] + v[i][1] * v[i][1] + v[i][2] * v[i][2] + v[i][3] * v[i][3]; }
#pragma unroll
    for (int off = 32; off >= 1; off >>= 1) ss += __shfl_xor(ss, off);
    const float rs = 1.0f / sqrtf(ss * (1.0f / DM) + 1e-6f);
#pragma unroll
    for (int i = 0; i < 4; ++i) {
      const f32x4 o = v[i] * rs * g[i];
      if (TO_BF16) { u32x2 w; w.x = pk2(o[0], o[1]); w.y = pk2(o[2], o[3]); *(u32x2*)(hout + (long)row * DM + i * 256 + lane * 4) = w; }
      else *(f32x4*)(fout + (long)row * DM + i * 256 + lane * 4) = o;
    }
  }
}

struct RowLinear { long ld; DI long operator()(int r) const { return (long)r * ld; } };
struct RowCmp { int off; DI long operator()(int r) const { const int g = r & 3, n = (r >> 2) & 127, b = r >> 9; return ((long)b * T + n * 16) * LDO + off + g * 64; } };
DI void store_bf4(bf16_t* dst, f32x4 v) { u32x2 w; w.x = pk2(v[0], v[1]); w.y = pk2(v[2], v[3]); *(u32x2*)dst = w; }

template <class RowMap, class Epi>
DI void gemm_tile128(char* smem, int tid, const bf16_t* A, RowMap rowmap, int a_kstep, const bf16_t* Bt, int ldb, int mt, int KT, Epi epi) {
  const int lane = tid & 63, wid = tid >> 6, wr = wid >> 1, wc = wid & 1, fr = lane & 15, fq = lane >> 4;
  bf16_t* sA = (bf16_t*)smem;
  bf16_t* sB = sA + 128 * 72;
  const bf16_t* ap[4]; const bf16_t* bp[4];
#pragma unroll
  for (int i = 0; i < 4; ++i) {
    const int c = tid + i * 256, r = c >> 3, cc = (c & 7) * 8;
    ap[i] = A + rowmap(mt * 128 + r) + cc;
    bp[i] = Bt + (long)r * ldb + cc;
  }
  f32x4 acc[4][4];
#pragma unroll
  for (int m = 0; m < 4; ++m)
#pragma unroll
    for (int n = 0; n < 4; ++n) acc[m][n] = (f32x4){0.f, 0.f, 0.f, 0.f};
  u32x4 ra[2][4], rb[2][4];
#pragma unroll
  for (int s = 0; s < 2; ++s)
    if (s < KT) {
#pragma unroll
      for (int i = 0; i < 4; ++i) { ra[s][i] = *(const u32x4*)(ap[i] + (long)s * a_kstep); rb[s][i] = *(const u32x4*)(bp[i] + s * 64); }
    }
  for (int kt3 = 0; kt3 < KT; kt3 += 2) {
#pragma unroll
    for (int s = 0; s < 2; ++s) {
      const int kt = kt3 + s;
      if (kt < KT) {
        __syncthreads();
#pragma unroll
        for (int i = 0; i < 4; ++i) {
          const int c = tid + i * 256, r = c >> 3, cc = (c & 7) * 8;
          *(u32x4*)(sA + r * 72 + cc) = ra[s][i];
          *(u32x4*)(sB + r * 72 + cc) = rb[s][i];
        }
        __syncthreads();
        if (kt + 2 < KT) {
#pragma unroll
          for (int i = 0; i < 4; ++i) { ra[s][i] = *(const u32x4*)(ap[i] + (long)(kt + 2) * a_kstep); rb[s][i] = *(const u32x4*)(bp[i] + (kt + 2) * 64); }
        }
#pragma unroll
        for (int ks = 0; ks < 2; ++ks) {
          bf16x8 af[4], bfr[4];
#pragma unroll
          for (int m = 0; m < 4; ++m) af[m] = *(const bf16x8*)(sA + (wr * 64 + m * 16 + fr) * 72 + ks * 32 + fq * 8);
#pragma unroll
          for (int n = 0; n < 4; ++n) bfr[n] = *(const bf16x8*)(sB + (wc * 64 + n * 16 + fr) * 72 + ks * 32 + fq * 8);
#pragma unroll
          for (int m = 0; m < 4; ++m)
#pragma unroll
            for (int n = 0; n < 4; ++n) acc[m][n] = mfma16(bfr[n], af[m], acc[m][n]);
        }
      }
    }
  }
  epi(acc, mt * 128 + wr * 64, wc * 64, lane);
}

struct EpiCmp1 {
  bf16_t* CH; const float* bias;
  DI void operator()(const f32x4 (&acc)[4][4], int row0, int col0, int lane) const {
    const int fr = lane & 15, fq = lane >> 4;
#pragma unroll
    for (int m = 0; m < 4; ++m)
#pragma unroll
      for (int n = 0; n < 4; ++n) {
        const f32x4 bv = *(const f32x4*)(bias + col0 + n * 16 + fq * 4);
        f32x4 o;
#pragma unroll
        for (int j = 0; j < 4; ++j) { const float x = acc[m][n][j] + bv[j]; o[j] = 0.5f * x * (1.0f + tanhf(0.7978845608028654f * (x + 0.044715f * x * x * x))); }
        store_bf4(CH + (long)(row0 + m * 16 + fr) * 128 + col0 + n * 16 + fq * 4, o);
      }
  }
};
struct EpiCmp2 {
  bf16_t* outp;
  DI void operator()(const f32x4 (&acc)[4][4], int row0, int col0, int lane) const {
    const int fr = lane & 15, fq = lane >> 4;
    if (col0 >= 64) return;
#pragma unroll
    for (int m = 0; m < 4; ++m) {
      const int row = row0 + m * 16 + fr;
      const bool dead = ((row >> 2) & 127) == 127;
#pragma unroll
      for (int n = 0; n < 4; ++n) store_bf4(outp + (long)row * 64 + col0 + n * 16 + fq * 4, dead ? (f32x4){0.f, 0.f, 0.f, 0.f} : acc[m][n]);
    }
  }
};

DI void cmp_phase(char* smem, const Params& p, int j) {
  const int t512 = otid(), half = t512 >> 8, tid = t512 & 255;
  if (obid() >= 64) return;
  const int tile = obid() * 2 + half, kv = tile >> 6, mt = tile & 63;
  char* sm = smem + half * 36864;
  if (kv == 0) gemm_tile128(sm, tid, p.Y, RowCmp{O_KC}, LDO, p.WC1 + (long)(j * 2 + 0) * 128 * 2048, 2048, mt, 32, EpiCmp1{p.CH, p.CB + (j * 2 + 0) * 128});
  else gemm_tile128(sm, tid, p.Y, RowCmp{O_VC}, LDO, p.WC1 + (long)(j * 2 + 1) * 128 * 2048, 2048, mt, 32, EpiCmp1{p.CH + 8192 * 128, p.CB + (j * 2 + 1) * 128});
  __threadfence();
  __syncthreads();
  if (kv == 0) gemm_tile128(sm, tid, p.CH, RowLinear{128}, 64, p.WC2 + (long)(j * 2 + 0) * 128 * 128, 128, mt, 2, EpiCmp2{p.KCMP});
  else gemm_tile128(sm, tid, p.CH + 8192 * 128, RowLinear{128}, 64, p.WC2 + (long)(j * 2 + 1) * 128 * 128, 128, mt, 2, EpiCmp2{p.VCMP});
}

namespace pg8 {
#define PG8_LAS __attribute__((address_space(3)))
constexpr int BM = 256, BK = 64, HALF = 128, HTB = HALF * BK * 2, STAGE_BYTES = 8 * HTB, NXCD = 8, WGM = 8;
__host__ __device__ __forceinline__ int lds_byte(int r, int c) { const int st = (r >> 4) * 2 + (c >> 5), rr = r & 15, cc = c & 31, ob = rr * 64 + cc * 2; return st * 1024 + (ob ^ (((ob >> 9) & 1) << 5)); }
__host__ __device__ __forceinline__ void stage_rc(int b, int& R, int& C) { const int st = b / 1024, sb = b % 1024, swz = sb ^ (((sb >> 9) & 1) << 5); R = (st >> 1) * 16 + swz / 64; C = (st & 1) * 32 + (swz % 64) / 2; }
__host__ __device__ __forceinline__ int perm32(int rho) { const int n = rho >> 4, i = rho & 15; return 8 * (i >> 2) + 4 * n + (i & 3); }
struct Unit { int pm, pn; };
struct Gemm { const bf16_t* A; const bf16_t* Bt; int M, N, K; };
struct StaticOrder {
    int nM, nN, nwg, G, c;
    __host__ __device__ void init(int M, int N, int G_, int c_) { nM = M / BM; nN = N / BM; nwg = nM * nN; G = G_; c = c_; }
    __host__ __device__ bool next(int i, Unit& u) const {
        const long L = (long)i * G + c; if (L >= nwg) return false;
        int wgid = (int)L; { const int q = nwg / NXCD, r = nwg % NXCD, xcd = wgid % NXCD, off = wgid / NXCD; wgid = (xcd < r ? xcd * (q + 1) : r * (q + 1) + (xcd - r) * q) + off; }
        const int nig = WGM * nN, gid = wgid / nig, fm = gid * WGM, gsz = (nM - fm) < WGM ? (nM - fm) : WGM;
        u.pm = fm + ((wgid % nig) % gsz); u.pn = (wgid % nig) / gsz; return true;
    }
    __device__ __forceinline__ void a_ready(const Unit&) const {}
    __device__ __forceinline__ void done(const Unit&) const {}
};
template <class Epi, class Sched, bool ALIGN_EPI = false, bool SP2 = false>
__device__ __forceinline__ void gemm_phase(PG8_LAS unsigned char* lds, const Gemm g, const Sched& S, const Epi& E) {
    const int tid = otid(), wid = __builtin_amdgcn_readfirstlane(tid >> 6), lane = tid & 63, wr = wid >> 2, wc = wid & 3, fr = lane & 15, fq = lane >> 4;
    const int K = g.K, nt = K / BK;
    unsigned voffA[2], voffB[2];
#pragma unroll
    for (int i = 0; i < 2; ++i) { int R, C; stage_rc(tid * 16 + i * 8192, R, C); const int Rb = Epi::PERM ? ((R & ~31) + perm32(R & 31)) : R;
        voffA[i] = (unsigned)(R * K + C) * 2u; voffB[i] = (unsigned)(Rb * K + C) * 2u; }
    const size_t kstep = (size_t)(BK * 2);
    const size_t hstep = (size_t)HALF * K * 2;
    const size_t tstep = 2 * hstep;
    const unsigned ldsw = (unsigned)wid * 1024u;
    const int aoff = lds_byte(wr * 64 + fr, fq * 8), boff = lds_byte(wc * 32 + fr, fq * 8);
#define PG8_SA(b, h) (((b) * 2 + (h)) * HTB)
#define PG8_SB(b, h) ((4 + (b) * 2 + (h)) * HTB)
#define PG8_STAGE(bufoff, gbase, voff) do { _Pragma("unroll") for (int _i = 0; _i < 2; ++_i) \
        __builtin_amdgcn_global_load_lds((const unsigned*)((const char*)(gbase) + (voff)[_i]), (PG8_LAS unsigned*)(lds + (bufoff) + ldsw + _i * 8192), 16, 0, 0); } while (0)
#define PG8_LDA(dst, b, h) do { _Pragma("unroll") for (int m = 0; m < 4; ++m) _Pragma("unroll") for (int k = 0; k < 2; ++k) dst[m][k] = *(const PG8_LAS bf16x8*)(lds + PG8_SA(b, h) + aoff + m * 2048 + k * 1024); } while (0)
#define PG8_LDB(dst, b, h) do { _Pragma("unroll") for (int n = 0; n < 2; ++n) _Pragma("unroll") for (int k = 0; k < 2; ++k) dst[n][k] = *(const PG8_LAS bf16x8*)(lds + PG8_SB(b, h) + boff + n * 2048 + k * 1024); } while (0)
#define PG8_MMA(ai, bj, At, Bt) do { __builtin_amdgcn_s_setprio(1); _Pragma("unroll") for (int m = 0; m < 4; ++m) _Pragma("unroll") for (int n = 0; n < 2; ++n) _Pragma("unroll") for (int k = 0; k < 2; ++k) \
        acc[ai][bj][m][n] = __builtin_amdgcn_mfma_f32_16x16x32_bf16(Bt[n][k], At[m][k], acc[ai][bj][m][n], 0, 0, 0); __builtin_amdgcn_s_setprio(0); } while (0)
#define PG8_WAIT_V(n) asm volatile("s_waitcnt vmcnt(" #n ")" ::: "memory")
#define PG8_WAIT_L(n) asm volatile("s_waitcnt lgkmcnt(" #n ")" ::: "memory")
#define PG8_BAR __builtin_amdgcn_s_barrier()
#define PG8_SCHED __builtin_amdgcn_sched_barrier(0)
    Unit cur, nxt; int ui = 0;
    if (!S.next(0, cur)) return;
    f32x4 acc[2][2][4][2];
#pragma unroll
    for (int a = 0; a < 2; ++a)
#pragma unroll
        for (int b = 0; b < 2; ++b)
#pragma unroll
            for (int m = 0; m < 4; ++m)
#pragma unroll
                for (int n = 0; n < 2; ++n) acc[a][b][m][n] = (f32x4){0.f, 0.f, 0.f, 0.f};
    bf16x8 At[4][2], B0[2][2], B1[2][2];
    const char* cA = (const char*)g.A + (size_t)cur.pm * tstep; const char* cB = (const char*)g.Bt + (size_t)cur.pn * tstep;
    S.a_ready(cur);
    if constexpr (SP2) {
        PG8_STAGE(PG8_SB(0, 0), cB, voffB); PG8_STAGE(PG8_SB(0, 1), cB + hstep, voffB); PG8_STAGE(PG8_SA(0, 0), cA, voffA); PG8_STAGE(PG8_SA(0, 1), cA + hstep, voffA);
        if (wr == 1) PG8_BAR;
        PG8_WAIT_V(2); PG8_BAR;
        PG8_STAGE(PG8_SB(1, 0), cB + kstep, voffB); PG8_STAGE(PG8_SA(1, 0), cA + kstep, voffA); PG8_STAGE(PG8_SB(1, 1), cB + hstep + kstep, voffB);
        PG8_WAIT_V(6); PG8_BAR;
    } else {
        PG8_STAGE(PG8_SB(0, 0), cB, voffB); PG8_STAGE(PG8_SA(0, 0), cA, voffA); PG8_STAGE(PG8_SB(0, 1), cB + hstep, voffB); PG8_STAGE(PG8_SA(0, 1), cA + hstep, voffA);
        if (wr == 1) PG8_BAR;
        PG8_WAIT_V(4); PG8_BAR;
        PG8_STAGE(PG8_SB(1, 0), cB + kstep, voffB); PG8_STAGE(PG8_SA(1, 0), cA + kstep, voffA); PG8_STAGE(PG8_SB(1, 1), cB + hstep + kstep, voffB);
        PG8_WAIT_V(6); PG8_BAR;
    }
    for (;;) {
        const bool has_next = S.next(ui + 1, nxt);
        const char* nA = has_next ? (const char*)g.A + (size_t)nxt.pm * tstep : cA; const char* nB = has_next ? (const char*)g.Bt + (size_t)nxt.pn * tstep : cB;
        for (int t = 0; t < nt; t += 2) {
            const bool last = (t == nt - 2);
            const char* a1 = cA + (size_t)(t + 1) * kstep;
            const char* a2 = last ? nA : cA + (size_t)(t + 2) * kstep; const char* b2 = last ? nB : cB + (size_t)(t + 2) * kstep;
            const char* a3 = a2 + kstep; const char* b3 = b2 + kstep;
            if (last && has_next) S.a_ready(nxt);
            if constexpr (SP2) {
            PG8_LDB(B0, 0, 0); PG8_LDB(B1, 0, 1); PG8_SCHED; PG8_LDA(At, 0, 0); PG8_STAGE(PG8_SA(1, 1), a1 + hstep, voffA);
            PG8_WAIT_V(8); PG8_WAIT_L(0); PG8_BAR; PG8_MMA(0, 0, At, B0); PG8_MMA(0, 1, At, B1); PG8_BAR; PG8_SCHED;
            PG8_LDA(At, 0, 1); PG8_STAGE(PG8_SB(0, 0), b2, voffB); PG8_STAGE(PG8_SB(0, 1), b2 + hstep, voffB); PG8_STAGE(PG8_SA(0, 0), a2, voffA);
            PG8_WAIT_V(8); PG8_WAIT_L(0); PG8_BAR; PG8_MMA(1, 0, At, B0); PG8_MMA(1, 1, At, B1); PG8_BAR; PG8_SCHED;
            PG8_LDB(B0, 1, 0); PG8_LDB(B1, 1, 1); PG8_SCHED; PG8_LDA(At, 1, 0); PG8_STAGE(PG8_SA(0, 1), a2 + hstep, voffA);
            PG8_WAIT_V(8); PG8_WAIT_L(0); PG8_BAR; PG8_MMA(0, 0, At, B0); PG8_MMA(0, 1, At, B1); PG8_BAR; PG8_SCHED;
            PG8_LDA(At, 1, 1); PG8_STAGE(PG8_SB(1, 0), b3, voffB); PG8_STAGE(PG8_SB(1, 1), b3 + hstep, voffB); PG8_STAGE(PG8_SA(1, 0), a3, voffA);
            PG8_WAIT_V(8); PG8_WAIT_L(0); PG8_BAR; PG8_MMA(1, 0, At, B0); PG8_MMA(1, 1, At, B1); PG8_BAR; PG8_SCHED;
            } else {
            PG8_LDB(B0, 0, 0); PG8_SCHED; PG8_LDA(At, 0, 0); PG8_STAGE(PG8_SA(1, 1), a1 + hstep, voffA);
            PG8_WAIT_L(8); PG8_BAR; PG8_WAIT_L(0); PG8_MMA(0, 0, At, B0); PG8_BAR; PG8_SCHED;
            PG8_LDB(B1, 0, 1); PG8_STAGE(PG8_SB(0, 0), b2, voffB);
            PG8_BAR; PG8_WAIT_L(0); PG8_MMA(0, 1, At, B1); PG8_BAR;
            PG8_LDA(At, 0, 1); PG8_STAGE(PG8_SA(0, 0), a2, voffA);
            PG8_BAR; PG8_WAIT_L(0); PG8_MMA(1, 0, At, B0); PG8_BAR; PG8_SCHED;
            PG8_STAGE(PG8_SB(0, 1), b2 + hstep, voffB);
            PG8_WAIT_V(6); PG8_BAR; PG8_MMA(1, 1, At, B1); PG8_BAR;
            PG8_LDB(B0, 1, 0); PG8_SCHED; PG8_LDA(At, 1, 0); PG8_STAGE(PG8_SA(0, 1), a2 + hstep, voffA);
            PG8_WAIT_L(8); PG8_BAR; PG8_WAIT_L(0); PG8_MMA(0, 0, At, B0); PG8_BAR; PG8_SCHED;
            PG8_LDB(B1, 1, 1); PG8_STAGE(PG8_SB(1, 0), b3, voffB);
            PG8_BAR; PG8_WAIT_L(0); PG8_MMA(0, 1, At, B1); PG8_BAR;
            PG8_LDA(At, 1, 1); PG8_STAGE(PG8_SA(1, 0), a3, voffA);
            PG8_BAR; PG8_WAIT_L(0); PG8_MMA(1, 0, At, B0); PG8_BAR; PG8_SCHED;
            PG8_STAGE(PG8_SB(1, 1), b3 + hstep, voffB);
            PG8_WAIT_V(6); PG8_BAR; PG8_MMA(1, 1, At, B1); PG8_BAR;
            }
        }
        if constexpr (ALIGN_EPI) { if (wr == 0) PG8_BAR; }
        if constexpr (!Epi::AFTER_DRAIN) { E(acc, cur, wr, wc, fr, fq); S.done(cur); }
        if (!has_next) break;
#pragma unroll
        for (int a = 0; a < 2; ++a)
#pragma unroll
            for (int b = 0; b < 2; ++b)
#pragma unroll
                for (int m = 0; m < 4; ++m)
#pragma unroll
                    for (int n = 0; n < 2; ++n) acc[a][b][m][n] = (f32x4){0.f, 0.f, 0.f, 0.f};
        cur = nxt; cA = nA; cB = nB; ++ui;
        if constexpr (ALIGN_EPI) { if (wr == 1) PG8_BAR; }
    }
    PG8_WAIT_V(0);
    if constexpr (!ALIGN_EPI) { if (wr == 0) PG8_BAR; }
    PG8_BAR;
    if constexpr (Epi::AFTER_DRAIN) { E.fused(acc, cur, wr, wc, fr, fq, lds, wid, lane); S.done(cur); }
#undef PG8_SA
#undef PG8_SB
#undef PG8_STAGE
#undef PG8_LDA
#undef PG8_LDB
#undef PG8_MMA
#undef PG8_WAIT_V
#undef PG8_WAIT_L
#undef PG8_BAR
#undef PG8_SCHED
}
}

struct EpiResid {
  static constexpr bool PERM = false, AFTER_DRAIN = false;
  const float* xin; float* xout;
  DI void operator()(const f32x4 (&acc)[2][2][4][2], const pg8::Unit& u, int wr, int wc, int fr_, int fq_) const {
    int fr = fr_, fq = fq_; asm volatile("" : "+v"(fr), "+v"(fq));
#pragma unroll
    for (int ai = 0; ai < 2; ++ai)
#pragma unroll
      for (int m = 0; m < 4; ++m) {
        const long rowoff = (long)(u.pm * 256 + ai * 128 + wr * 64 + m * 16 + fr) * DM + u.pn * 256 + wc * 32 + fq * 4;
#pragma unroll
        for (int bj = 0; bj < 2; ++bj)
#pragma unroll
          for (int n = 0; n < 2; ++n) {
            const long off = rowoff + bj * 128 + n * 16;
            *(f32x4*)(xout + off) = *(const f32x4*)(xin + off) + acc[ai][bj][m][n];
          }
      }
  }
};

struct EpiSwiglu {
  static constexpr bool PERM = false, AFTER_DRAIN = false;
  bf16_t* hid;
  DI void operator()(const f32x4 (&acc)[2][2][4][2], const pg8::Unit& u, int wr, int wc, int fr_, int fq_) const {
    int fr = fr_, fq = fq_; asm volatile("" : "+v"(fr), "+v"(fq));
#pragma unroll
    for (int ai = 0; ai < 2; ++ai)
#pragma unroll
      for (int m = 0; m < 4; ++m) {
        bf16_t* rowp = hid + (long)(u.pm * 256 + ai * 128 + wr * 64 + m * 16 + fr) * DFF + u.pn * 128 + wc * 16 + fq * 4;
#pragma unroll
        for (int bj = 0; bj < 2; ++bj) {
          f32x4 o;
#pragma unroll
          for (int j = 0; j < 4; ++j) { const float g = acc[ai][bj][m][0][j], uu = acc[ai][bj][m][1][j]; o[j] = g / (1.0f + __expf(-g)) * uu; }
          store_bf4(rowp + bj * 64, o);
        }
      }
  }
};

constexpr float QS_A = 0.10206207261596577f * LOG2E;
constexpr float QS_8 = 0.125f * LOG2E;

DI void rope_pair_store(bf16_t* d1, bf16_t* d2, f32x4 x1, f32x4 x2, const float* cosr, const float* sinr, float sc) {
  const f32x4 cs = *(const f32x4*)cosr, sn = *(const f32x4*)sinr;
  store_bf4(d1, (x1 * cs - x2 * sn) * sc);
  store_bf4(d2, (x2 * cs + x1 * sn) * sc);
}

struct EpiEven {
  static constexpr bool PERM = false, AFTER_DRAIN = false;
  bf16_t* Y; float* IW; const float* kv_gain; const float *cos64, *sin64, *cos32, *sin32; float* red;
  DI void operator()(const f32x4 (&acc)[2][2][4][2], const pg8::Unit& u, int wr, int wc, int fr_, int fq_) const {
    int fr = fr_, fq = fq_; asm volatile("" : "+v"(fr), "+v"(fq));
    if (u.pn == 3) {
#pragma unroll
      for (int ai = 0; ai < 2; ++ai)
#pragma unroll
        for (int m = 0; m < 4; ++m) {
          float ss = 0.f;
#pragma unroll
          for (int n = 0; n < 2; ++n)
#pragma unroll
            for (int j = 0; j < 4; ++j) ss += acc[ai][0][m][n][j] * acc[ai][0][m][n][j];
          ss += __shfl_xor(ss, 16); ss += __shfl_xor(ss, 32);
          if (fq == 0) red[wc * 256 + ai * 128 + wr * 64 + m * 16 + fr] = ss;
        }
      asm volatile("s_waitcnt lgkmcnt(0)" ::: "memory"); __builtin_amdgcn_s_barrier(); asm volatile("" ::: "memory");
#pragma unroll
      for (int ai = 0; ai < 2; ++ai)
#pragma unroll
        for (int m = 0; m < 4; ++m) {
          const int rl = ai * 128 + wr * 64 + m * 16 + fr;
          const float tot = (red[rl] + red[256 + rl]) + (red[512 + rl] + red[768 + rl]);
          const float rs = 1.0f / sqrtf(tot * (1.0f / 128.0f) + 1e-6f);
          bf16_t* dst = Y + (long)(u.pm * 256 + rl) * LDE + E_CKV + wc * 32 + fq * 4;
#pragma unroll
          for (int n = 0; n < 2; ++n) {
            const f32x4 gn = *(const f32x4*)(kv_gain + wc * 32 + n * 16 + fq * 4);
            store_bf4(dst + n * 16, acc[ai][0][m][n] * rs * gn);
          }
        }
    }
#pragma unroll
    for (int bj = 0; bj < 2; ++bj) {
      const int nc = u.pn * 256 + bj * 128 + wc * 32;
      if (nc >= E_CKV && nc < E_KROPE) continue;
#pragma unroll
      for (int ai = 0; ai < 2; ++ai)
#pragma unroll
        for (int m = 0; m < 4; ++m) {
          const int row = u.pm * 256 + ai * 128 + wr * 64 + m * 16 + fr, pos = row & (T - 1);
          bf16_t* yr = Y + (long)row * LDE;
          const f32x4 x1 = acc[ai][bj][m][0], x2 = acc[ai][bj][m][1];
          if (nc < E_QROPE) {
            store_bf4(yr + nc + fq * 4, x1); store_bf4(yr + nc + 16 + fq * 4, x2);
          } else if (nc < E_CKV) {
            rope_pair_store(yr + nc + fq * 4, yr + nc + 16 + fq * 4, x1, x2, cos32 + pos * 16 + fq * 4, sin32 + pos * 16 + fq * 4, QS_A);
          } else if (nc == E_KROPE) {
            rope_pair_store(yr + nc + fq * 4, yr + nc + 16 + fq * 4, x1, x2, cos32 + pos * 16 + fq * 4, sin32 + pos * 16 + fq * 4, 1.0f);
          } else if (nc < E_VB) {
            const int s0 = nc < E_QB ? E_IQ : E_QB, rel = nc - s0, hb = s0 + (rel & ~63), i0 = ((rel >> 5) & 1) * 16 + fq * 4;
            const float sc = (nc >= E_QB && nc < E_KB) ? QS_8 : 1.0f;
            rope_pair_store(yr + hb + i0, yr + hb + 32 + i0, x1, x2, cos64 + pos * 32 + i0, sin64 + pos * 32 + i0, sc);
          } else if (nc < E_IW) {
            store_bf4(yr + nc + fq * 4, x1); store_bf4(yr + nc + 16 + fq * 4, x2);
          } else {
            if (fq < 2) *(f32x4*)(IW + (long)row * 8 + fq * 4) = x1 * 0.35355339059327373f;
          }
          asm volatile("" ::: "memory");
        }
    }
  }
};

struct EpiOdd {
  static constexpr bool PERM = false, AFTER_DRAIN = false;
  bf16_t* Y; float* GATES; const float *cos64, *sin64;
  DI void operator()(const f32x4 (&acc)[2][2][4][2], const pg8::Unit& u, int wr, int wc, int fr_, int fq_) const {
    int fr = fr_, fq = fq_; asm volatile("" : "+v"(fr), "+v"(fq));
#pragma unroll
    for (int bj = 0; bj < 2; ++bj) {
      const int nc = u.pn * 256 + bj * 128 + wc * 32;
      if (nc >= 2624) continue;
#pragma unroll
      for (int ai = 0; ai < 2; ++ai)
#pragma unroll
        for (int m = 0; m < 4; ++m) {
          const int row = u.pm * 256 + ai * 128 + wr * 64 + m * 16 + fr, pos = row & (T - 1);
          bf16_t* yr = Y + (long)row * LDO;
          const f32x4 x1 = acc[ai][bj][m][0], x2 = acc[ai][bj][m][1];
          const int sec = nc < O_KC ? 0 : ((nc - O_KC) >> 8);
          if (nc < O_KC || (nc < O_G && (sec & 1) == 0)) {
            const int hb = nc & ~63, i0 = ((nc >> 5) & 1) * 16 + fq * 4;
            rope_pair_store(yr + hb + i0, yr + hb + 32 + i0, x1, x2, cos64 + pos * 32 + i0, sin64 + pos * 32 + i0, nc < O_KC ? QS_8 : 1.0f);
          } else if (nc < O_G) {
            store_bf4(yr + nc + fq * 4, x1); store_bf4(yr + nc + 16 + fq * 4, x2);
          } else {
            const int gc = nc - O_G;
            f32x4 o;
#pragma unroll
            for (int j = 0; j < 4; ++j) o[j] = 1.0f / (1.0f + __expf(-x1[j]));
            *(f32x4*)(GATES + (long)row * 48 + gc + fq * 4) = o;
            if (gc == 0) {
#pragma unroll
              for (int j = 0; j < 4; ++j) o[j] = 1.0f / (1.0f + __expf(-x2[j]));
              *(f32x4*)(GATES + (long)row * 48 + 16 + fq * 4) = o;
            }
          }
          asm volatile("" ::: "memory");
        }
    }
  }
};

template <class Epi>
DI void big_gemm(unsigned char* lds, const bf16_t* A, const bf16_t* Bt, int N, int K, const Epi& E) {
  pg8::Gemm g{A, Bt, NTOK, N, K};
  pg8::StaticOrder S; S.init(NTOK, N, (int)gridDim.x, obid());
  pg8::gemm_phase<Epi, pg8::StaticOrder, true, true>((PG8_LAS unsigned char*)lds, g, S, E);
}

DI int crow(int i, int h) { return (i & 3) + 8 * (i >> 2) + 4 * h; }
DI int vt_pos(int g4) { const int gi = g4 & 3; return (g4 >> 2) * 16 + (gi & 1) * 8 + (gi >> 1) * 4; }
DI void vt_write(bf16_t* sVt, int vst, int d0, int pos, const u32x4 (&kv)[4]) {
#pragma unroll
  for (int w = 0; w < 4; ++w) {
    u32x2 lo, hi;
    lo.x = (kv[0][w] & 0xffffu) | (kv[1][w] << 16); lo.y = (kv[2][w] & 0xffffu) | (kv[3][w] << 16);
    hi.x = (kv[0][w] >> 16) | (kv[1][w] & 0xffff0000u); hi.y = (kv[2][w] >> 16) | (kv[3][w] & 0xffff0000u);
    *(u32x2*)(sVt + (d0 + 2 * w) * vst + pos) = lo;
    *(u32x2*)(sVt + (d0 + 2 * w + 1) * vst + pos) = hi;
  }
}

DI void vt_write2(bf16_t* sVt, int vst, int d0, int pos, const u32x4 (&kv)[2]) {
#pragma unroll
  for (int w = 0; w < 4; ++w) {
    const unsigned lo = (kv[0][w] & 0xffffu) | (kv[1][w] << 16);
    const unsigned hi = (kv[0][w] >> 16) | (kv[1][w] & 0xffff0000u);
    *(unsigned*)(sVt + (d0 + 2 * w) * vst + pos) = lo;
    *(unsigned*)(sVt + (d0 + 2 * w + 1) * vst + pos) = hi;
  }
}
template <int NKS, int NDB, bool MASKED, class VF>
DI void flash_tile(f32x16 (&o)[NDB], f32x16& negref, float& mrun, float& l, const bf16x8 (&qf)[NKS], const bf16_t* sK, int kst, const bf16_t* sVt, int vst, VF valid) {
  const int lane = otid() & 63, r = lane & 31, h = lane >> 5;
  f32x16 s[2];
#pragma unroll
  for (int kb = 0; kb < 2; ++kb) {
#pragma unroll
    for (int ks = 0; ks < NKS; ++ks) {
      const bf16x8 a = *(const bf16x8*)(sK + (kb * 32 + r) * kst + ks * 16 + h * 8);
      if (ks == 0) s[kb] = mfma32(a, qf[0], negref); else s[kb] = mfma32(a, qf[ks], s[kb]);
    }
    __builtin_amdgcn_sched_barrier(0);
  }
  float mx = NEG_INF;
#pragma unroll
  for (int kb = 0; kb < 2; ++kb)
#pragma unroll
    for (int i = 0; i < 16; ++i) {
      if (MASKED) { const float sv = valid(kb, i) ? s[kb][i] : NEG_INF; s[kb][i] = sv; }
      mx = fmaxf(mx, s[kb][i]);
    }
  mx = fmaxf(mx, __shfl_xor(mx, 32));
  float mr = fmaxf(mrun, mx);
  const bool need = (mr > 8.0f) || (mr < -8.0f && mr != NEG_INF);
  if (__ballot(need) != 0ull) {
    const float delta = need ? mr : 0.f;
    const float alpha = ex2(-delta);
#pragma unroll
    for (int kb = 0; kb < 2; ++kb)
#pragma unroll
      for (int i = 0; i < 16; ++i) s[kb][i] -= delta;
#pragma unroll
    for (int db = 0; db < NDB; ++db)
#pragma unroll
      for (int i = 0; i < 16; ++i) o[db][i] *= alpha;
#pragma unroll
    for (int i = 0; i < 16; ++i) negref[i] -= delta;
    l *= alpha;
    mr -= delta;
  }
  mrun = mr;
  float ps = 0.f;
#pragma unroll
  for (int kb = 0; kb < 2; ++kb)
#pragma unroll
    for (int i = 0; i < 16; ++i) { const float pv = ex2(s[kb][i]); s[kb][i] = pv; ps += pv; }
  l += ps;
  __builtin_amdgcn_sched_barrier(0);
#pragma unroll
  for (int kb = 0; kb < 2; ++kb)
#pragma unroll
    for (int s2 = 0; s2 < 2; ++s2) {
      u32x4 pw;
#pragma unroll
      for (int jj = 0; jj < 4; ++jj) pw[jj] = pk2(s[kb][8 * s2 + 2 * jj], s[kb][8 * s2 + 2 * jj + 1]);
      const bf16x8 pf = __builtin_bit_cast(bf16x8, pw);
#pragma unroll
      for (int db = 0; db < NDB; ++db) {
        const bf16x8 a = *(const bf16x8*)(sVt + (db * 32 + r) * vst + kb * 32 + s2 * 16 + h * 8);
        o[db] = mfma32(a, pf, o[db]);
      }
      __builtin_amdgcn_sched_barrier(0);
    }
}
template <int NKS, int NDB, int MASKED, class VF, bool REFC = true>
DI void qk_softmax(u32x4 (&pw)[4], f32x16 (&o)[NDB], f32x16& negref, float& mrun, float& l, const bf16x8 (&qf)[NKS], const bf16_t* sK, int kst, VF valid, bool rowok = true) {
  const int lane = otid() & 63, r = lane & 31, h = lane >> 5;
  f32x16 s[2];
  constexpr int KG = (NKS == 4) ? 4 : 2;
#pragma unroll
  for (int k0 = 0; k0 < NKS; k0 += KG) {
    bf16x8 a[2][KG];
#pragma unroll
    for (int kb = 0; kb < 2; ++kb)
#pragma unroll
      for (int kk = 0; kk < KG; ++kk)
        if (k0 + kk < NKS) a[kb][kk] = *(const bf16x8*)(sK + (kb * 32 + r) * kst + (k0 + kk) * 16 + h * 8);
    __builtin_amdgcn_sched_group_barrier(0x100, 2 * KG, 0);
#pragma unroll
    for (int kk = 0; kk < KG; ++kk)
#pragma unroll
      for (int kb = 0; kb < 2; ++kb)
        if (k0 + kk < NKS) {
          if (k0 + kk == 0) {
            if (REFC) s[kb] = mfma32(a[kb][kk], qf[0], negref);
            else { f32x16 z; _Pragma("unroll") for (int i_ = 0; i_ < 16; ++i_) z[i_] = 0.f; s[kb] = mfma32(a[kb][kk], qf[0], z); }
          } else s[kb] = mfma32(a[kb][kk], qf[k0 + kk], s[kb]);
        }
    __builtin_amdgcn_sched_group_barrier(0x008, 2 * KG, 0);
  }
  if (!REFC) {
#pragma unroll
    for (int kb = 0; kb < 2; ++kb)
#pragma unroll
      for (int i = 0; i < 16; ++i) s[kb][i] += negref[0];
  }
  float mx = NEG_INF;
#pragma unroll
  for (int kb = 0; kb < 2; ++kb)
#pragma unroll
    for (int i = 0; i < 16; ++i) {
      if (MASKED == 1) { const float sv = valid(kb, i) ? s[kb][i] : NEG_INF; s[kb][i] = sv; }
      mx = fmaxf(mx, s[kb][i]);
    }
  if (MASKED == 2) mx = rowok ? mx : NEG_INF;
  mx = fmaxf(mx, __shfl_xor(mx, 32));
  float mr = fmaxf(mrun, mx);
  const bool need = (mr > 8.0f) || (mr < -8.0f && mr != NEG_INF);
  if (__ballot(need) != 0ull) {
    const float delta = need ? mr : 0.f;
    const float alpha = ex2(-delta);
#pragma unroll
    for (int kb = 0; kb < 2; ++kb)
#pragma unroll
      for (int i = 0; i < 16; ++i) s[kb][i] -= delta;
#pragma unroll
    for (int db = 0; db < NDB; ++db)
#pragma unroll
      for (int i = 0; i < 16; ++i) o[db][i] *= alpha;
#pragma unroll
    for (int i = 0; i < 16; ++i) negref[i] -= delta;
    l *= alpha;
    mr -= delta;
  }
  mrun = mr;
  float ps = 0.f;
#pragma unroll
  for (int kb = 0; kb < 2; ++kb)
#pragma unroll
    for (int i = 0; i < 16; ++i) { const float pv = ex2(s[kb][i]); s[kb][i] = pv; ps += pv; }
  if (MASKED == 2) ps = rowok ? ps : 0.f;
  l += ps;
#pragma unroll
  for (int kb = 0; kb < 2; ++kb)
#pragma unroll
    for (int s2 = 0; s2 < 2; ++s2)
#pragma unroll
      for (int jj = 0; jj < 4; ++jj) {
        const unsigned w = pk2(s[kb][8 * s2 + 2 * jj], s[kb][8 * s2 + 2 * jj + 1]);
        pw[kb * 2 + s2][jj] = (MASKED == 2) ? (rowok ? w : 0u) : w;
      }
}
template <int NKS, int NDB, int MASKED, class VF>
DI void qk_softmax_s(u32x4 (&pw)[4], f32x16 (&o)[NDB], f32x16& negref, float& mrun, float& l, const bf16x8 (&qf)[NKS], const bf16_t* sK, int kst, VF valid) {
  qk_softmax<NKS, NDB, MASKED, VF, true>(pw, o, negref, mrun, l, qf, sK, kst, valid);
}
template <int NDB>
DI void pv_tile(f32x16 (&o)[NDB], const u32x4 (&pw)[4], const bf16_t* sVt, int vst) {
  const int lane = otid() & 63, r = lane & 31, h = lane >> 5;
#pragma unroll
  for (int kb = 0; kb < 2; ++kb)
#pragma unroll
    for (int s2 = 0; s2 < 2; ++s2) {
      const bf16x8 pf = __builtin_bit_cast(bf16x8, pw[kb * 2 + s2]);
      bf16x8 a[NDB];
#pragma unroll
      for (int db = 0; db < NDB; ++db) a[db] = *(const bf16x8*)(sVt + (db * 32 + r) * vst + kb * 32 + s2 * 16 + h * 8);
      __builtin_amdgcn_sched_group_barrier(0x100, NDB, 0);
#pragma unroll
      for (int db = 0; db < NDB; ++db) o[db] = mfma32(a[db], pf, o[db]);
      __builtin_amdgcn_sched_group_barrier(0x008, NDB, 0);
    }
}
DI bool wave_skew(int wid) { return (((wid & 1) ^ (wid >> 2)) & 1) != 0; }

#define FLASH_STATE(NDB) f32x16 o[NDB]; f32x16 negref; float mrun = NEG_INF, l = 0.f; \
  _Pragma("unroll") for (int i_ = 0; i_ < 16; ++i_) { negref[i_] = 0.f; _Pragma("unroll") for (int db_ = 0; db_ < NDB; ++db_) o[db_][i_] = 0.f; }

DI void idx_phase(char* smem, const Params& p) {
  const int tid = otid(), lane = tid & 63, wid = tid >> 6, fr = lane & 15, fq = lane >> 4;
  unsigned* hw = (unsigned*)smem + wid * 2048;
  float* scr = p.SCR + (long)obid() * 16 * 2048;
  for (int rnd = 0; rnd * (int)gridDim.x < NB * 128; ++rnd) {
    const int it = rnd * (int)gridDim.x + ((rnd & 1) ? ((int)gridDim.x - 1 - obid()) : obid());
    if (it >= NB * 128) break;
    const int qt = 127 - it / NB, b = it % NB, q0 = qt * 16;
    const bf16_t* yb = p.Y + (long)b * T * LDE;
    bf16x8 qf[8][2];
#pragma unroll
    for (int hh = 0; hh < 8; ++hh)
#pragma unroll
      for (int ks = 0; ks < 2; ++ks) qf[hh][ks] = *(const bf16x8*)(yb + (long)(q0 + fr) * LDE + E_IQ + hh * 64 + ks * 32 + fq * 8);
    float w[8];
    {
      const f32x4 w0 = *(const f32x4*)(p.IW + ((long)b * T + q0 + fr) * 8), w1 = *(const f32x4*)(p.IW + ((long)b * T + q0 + fr) * 8 + 4);
      w[0] = w0[0]; w[1] = w0[1]; w[2] = w0[2]; w[3] = w0[3]; w[4] = w1[0]; w[5] = w1[1]; w[6] = w1[2]; w[7] = w1[3];
    }
    __syncthreads();
    {
      const bf16_t* kbase = yb + (long)fr * LDE + E_IK + fq * 8;
      bf16x8 kf[2], nf[2];
      int kt = wid;
      if (kt <= qt) { kf[0] = *(const bf16x8*)(kbase + (long)(kt * 16) * LDE); kf[1] = *(const bf16x8*)(kbase + (long)(kt * 16) * LDE + 32); }
      for (; kt <= qt; kt += 8) {
        if (kt + 8 <= qt) { nf[0] = *(const bf16x8*)(kbase + (long)((kt + 8) * 16) * LDE); nf[1] = *(const bf16x8*)(kbase + (long)((kt + 8) * 16) * LDE + 32); }
        f32x4 sc = {0.f, 0.f, 0.f, 0.f};
#pragma unroll
        for (int hh = 0; hh < 8; ++hh) {
          f32x4 a = {0.f, 0.f, 0.f, 0.f};
          a = mfma16(kf[0], qf[hh][0], a);
          a = mfma16(kf[1], qf[hh][1], a);
#pragma unroll
          for (int j = 0; j < 4; ++j) sc[j] += fmaxf(a[j], 0.f) * w[hh];
        }
        *(f32x4*)(scr + fr * 2048 + kt * 16 + fq * 4) = sc;
        kf[0] = nf[0]; kf[1] = nf[1];
      }
    }
    __syncthreads();
#pragma unroll 1
    for (int qq = 0; qq < 2; ++qq) {
      const int ql = wid * 2 + qq, t = q0 + ql;
      u64* outw = p.SEL + ((long)b * T + t) * 32;
      if (t < 256) {
        if (lane < 32) { const int lo = lane * 64; outw[lane] = (t >= lo + 63) ? ~0ull : (t < lo ? 0ull : ((1ull << (t - lo + 1)) - 1ull)); }
        continue;
      }
      const int ne = (t >> 6) + 1;
      unsigned key[32];
      float sv[32];
#pragma unroll
      for (int e = 0; e < 32; ++e) sv[e] = scr[ql * 2048 + e * 64 + lane];
#pragma unroll
      for (int e = 0; e < 32; ++e) {
        const int s = e * 64 + lane;
        const float v = sv[e] + 0.0f;
        unsigned u = __float_as_uint(v);
        u = (u & 0x80000000u) ? ~u : (u | 0x80000000u);
        key[e] = (s <= t) ? u : 0u;
      }
      unsigned prefix = 0; unsigned kk = 256; int sh = 32; bool whole = false;
#pragma unroll 1
      for (int pass = 0; pass < 4; ++pass) {
        const int shift = 24 - 8 * pass;
#pragma unroll
        for (int k = 0; k < 8; ++k) *(u32x4*)(hw + lane * 4 + k * 256) = (u32x4){0u, 0u, 0u, 0u};
#pragma unroll
        for (int e = 0; e < 32; ++e) {
          if (e < ne) {
            const unsigned u = key[e];
            const bool match = (pass == 0) || ((u >> (shift + 8)) == prefix);
            if (match) atomicAdd(hw + ((u >> shift) & 255u) * 8 + (lane & 7), 1u);
          }
        }
        u32x4 c;
#pragma unroll
        for (int bb = 0; bb < 4; ++bb) {
          const u32x4 s0 = *(const u32x4*)(hw + lane * 32 + bb * 8), s1 = *(const u32x4*)(hw + lane * 32 + bb * 8 + 4);
          c[bb] = ((s0[0] + s0[1]) + (s0[2] + s0[3])) + ((s1[0] + s1[1]) + (s1[2] + s1[3]));
        }
        const unsigned S = c[0] + c[1] + c[2] + c[3];
        unsigned Tl = S;
#pragma unroll
        for (int off = 1; off < 64; off <<= 1) { const unsigned v = __shfl_down(Tl, off); if (lane + off < 64) Tl += v; }
        unsigned a = Tl - S; int found = -1; unsigned nk = 0, cb = 0;
        if (a < kk && a + c[3] >= kk) { found = 3; nk = kk - a; cb = c[3]; } a += c[3];
        if (found < 0 && a < kk && a + c[2] >= kk) { found = 2; nk = kk - a; cb = c[2]; } a += c[2];
        if (found < 0 && a < kk && a + c[1] >= kk) { found = 1; nk = kk - a; cb = c[1]; } a += c[1];
        if (found < 0 && a < kk && a + c[0] >= kk) { found = 0; nk = kk - a; cb = c[0]; }
        const u64 bal = __ballot(found >= 0);
        const int src = __ffsll((long long)bal) - 1;
        const unsigned digit = (unsigned)__shfl(lane * 4 + found, src);
        kk = (unsigned)__shfl((int)nk, src);
        const unsigned cbin = (unsigned)__shfl((int)cb, src);
        prefix = (prefix << 8) | digit;
        sh = shift;
        if (cbin == kk) { whole = true; break; }
      }
      unsigned run = 0; u64 myword = 0;
      if (whole) {
#pragma unroll
        for (int e = 0; e < 32; ++e) {
          if (e < ne) {
            const u64 wsel = __ballot((key[e] >> sh) >= prefix);
            if (lane == e) myword = wsel;
          }
        }
      } else
#pragma unroll
      for (int e = 0; e < 32; ++e) {
        if (e < ne) {
          const unsigned u = key[e] >> sh;
          const bool eq = (u == prefix);
          const u64 be = __ballot(eq);
          const unsigned rank = run + (unsigned)__popcll(be & ((1ull << lane) - 1ull));
          const bool selb = (u > prefix) || (eq && rank < kk);
          const u64 wsel = __ballot(selb);
          run += (unsigned)__popcll(be);
          if (lane == e) myword = wsel;
        }
      }
      if (lane < 32) outw[lane] = myword;
    }
  }
}

constexpr int DSA_BUF = 39936;
DI void dsa_phase(char* smem, const Params& p, int j) {
  bf16_t* sK = (bf16_t*)smem;
  bf16_t* sVt = sK + 64 * 168;
  const int tid = otid(), lane = tid & 63, wid = tid >> 6, r = lane & 31, h = lane >> 5;
  const bool ldv = tid < 256, skew = wave_skew(wid);
  for (int rnd = 0; rnd * (int)gridDim.x < NB * 64; ++rnd) {
    const int it = rnd * (int)gridDim.x + ((rnd & 1) ? ((int)gridDim.x - 1 - obid()) : obid());
    if (it >= NB * 64) break;
    const int qt = 63 - it / NB, b = it % NB;
    const int tl = otid();
    const int g4 = tl & 15, dg = (tl >> 4) & 15, rk = (tl & 255) >> 2, rc = tl & 3;
    const int head = wid, q0 = qt * 32, tq = q0 + r;
    const bf16_t* yb = p.Y + (long)b * T * LDE;
    bf16x8 qf[10];
    {
      bf16x8 qn[4];
#pragma unroll
      for (int ks = 0; ks < 4; ++ks) qn[ks] = *(const bf16x8*)(yb + (long)tq * LDE + E_QNOPE + head * 64 + ks * 16 + h * 8);
      const bf16_t* wuk = p.WUKT + ((long)(j * 8 + head) * 128 + r) * 64 + h * 8;
#pragma unroll
      for (int cb = 0; cb < 4; ++cb) {
        int cbo = cb * 32 * 64;
        asm volatile("" : "+v"(cbo));
        const bf16_t* wk = wuk + cbo;
        f32x16 ql;
#pragma unroll
        for (int i = 0; i < 16; ++i) ql[i] = 0.f;
#pragma unroll
        for (int ks = 0; ks < 4; ++ks) { const bf16x8 a = *(const bf16x8*)(wk + ks * 16); ql = mfma32(a, qn[ks], ql); }
#pragma unroll
        for (int s2 = 0; s2 < 2; ++s2) {
          u32x4 w;
#pragma unroll
          for (int jj = 0; jj < 4; ++jj) w[jj] = pk2(ql[8 * s2 + 2 * jj] * QS_A, ql[8 * s2 + 2 * jj + 1] * QS_A);
          qf[cb * 2 + s2] = __builtin_bit_cast(bf16x8, w);
        }
        __builtin_amdgcn_sched_barrier(0);
      }
    }
    __builtin_amdgcn_sched_barrier(0);
    int tq2 = tq; asm volatile("" : "+v"(tq2));
#pragma unroll
    for (int ks = 0; ks < 2; ++ks) qf[8 + ks] = *(const bf16x8*)(yb + (long)tq2 * LDE + E_QROPE + head * 32 + ks * 16 + h * 8);
    const u64* selrow = p.SEL + ((long)b * T + tq2) * 32;
    FLASH_STATE(4)
    const int nkt = ((q0 + 31) >> 6) + 1;
    u32x4 kv[4];
    auto issue = [&](int kt) {
      const bf16_t* base = yb + (long)(kt * 64) * LDE + E_CKV;
      if (ldv) {
#pragma unroll
        for (int i = 0; i < 4; ++i) kv[i] = *(const u32x4*)(base + (long)(g4 * 4 + i) * LDE + dg * 8);
      } else kv[0] = *(const u32x4*)(base + (long)rk * LDE + 128 + rc * 8);
    };
    auto stash = [&](int buf) {
      bf16_t* bK = sK + buf * (DSA_BUF / 2); bf16_t* bV = sVt + buf * (DSA_BUF / 2);
      if (ldv) {
#pragma unroll
        for (int i = 0; i < 4; ++i) {
          bf16_t* rowp = bK + (g4 * 4 + i) * 168 + (dg >> 1) * 16 + (dg & 1) * 4;
          *(u32x2*)rowp = (u32x2){kv[i][0], kv[i][1]};
          *(u32x2*)(rowp + 8) = (u32x2){kv[i][2], kv[i][3]};
        }
        vt_write(bV, 72, dg * 8, vt_pos(g4), kv);
      } else *(u32x4*)(bK + rk * 168 + 128 + rc * 8) = kv[0];
    };
    issue(0);
    __syncthreads();
    stash(0);
    if (nkt > 1) issue(1);
    __syncthreads();
    u32x4 pw[4];
    u64 word = selrow[0];
    for (int kt = 0; kt < nkt; ++kt) {
      const int buf = kt % 3;
      const u64 wnext = selrow[kt + 1 < nkt ? kt + 1 : kt];
      const unsigned wlo = (unsigned)word >> (4 * h), whi = (unsigned)(word >> 32) >> (4 * h);
      if (skew) {
        if (kt > 0) pv_tile<4>(o, pw, sVt + ((kt - 1) % 3) * (DSA_BUF / 2), 72);
        qk_softmax_s<10, 4, 1>(pw, o, negref, mrun, l, qf, sK + buf * (DSA_BUF / 2), 168, [&](int kb, int i) { return (((kb ? whi : wlo) >> ((i & 3) + 8 * (i >> 2))) & 1u) != 0u; });
      } else {
        qk_softmax_s<10, 4, 1>(pw, o, negref, mrun, l, qf, sK + buf * (DSA_BUF / 2), 168, [&](int kb, int i) { return (((kb ? whi : wlo) >> ((i & 3) + 8 * (i >> 2))) & 1u) != 0u; });
        pv_tile<4>(o, pw, sVt + buf * (DSA_BUF / 2), 72);
      }
      word = wnext;
      if (kt + 1 < nkt) {
        stash((kt + 1) % 3);
        if (kt + 2 < nkt) issue(kt + 2);
        __syncthreads();
      }
    }
    if (skew) pv_tile<4>(o, pw, sVt + ((nkt - 1) % 3) * (DSA_BUF / 2), 72);
    l += __shfl_xor(l, 32);
    const float inv = l > 0.f ? 1.0f / l : 0.f;
    u32x4 pwv[8];
#pragma unroll
    for (int db = 0; db < 4; ++db)
#pragma unroll
      for (int s2 = 0; s2 < 2; ++s2)
#pragma unroll
        for (int jj = 0; jj < 4; ++jj) pwv[db * 2 + s2][jj] = pk2(o[db][8 * s2 + 2 * jj] * inv, o[db][8 * s2 + 2 * jj + 1] * inv);
    asm volatile("" ::: "memory");
    int r2 = r, h2 = h, head2 = head, b2 = b; asm volatile("" : "+v"(r2), "+v"(h2), "+v"(head2), "+s"(b2));
    const bf16_t* wuv = p.WUVP + ((long)(j * 8 + head2) * 64 + r2) * 128 + h2 * 8;
    f32x16 oo[2];
#pragma unroll
    for (int dblk = 0; dblk < 2; ++dblk) {
#pragma unroll
      for (int i = 0; i < 16; ++i) oo[dblk][i] = 0.f;
#pragma unroll
      for (int ks = 0; ks < 8; ++ks) {
        const bf16x8 a = *(const bf16x8*)(wuv + (long)dblk * 32 * 128 + ks * 16);
        oo[dblk] = mfma32(a, __builtin_bit_cast(bf16x8, pwv[ks]), oo[dblk]);
      }
    }
    bf16_t* orow = p.O + ((long)b2 * T + q0 + r2) * DM + head2 * 64;
#pragma unroll
    for (int dblk = 0; dblk < 2; ++dblk)
#pragma unroll
      for (int g = 0; g < 4; ++g)
        store_bf4(orow + dblk * 32 + 8 * g + 4 * h2, (f32x4){oo[dblk][4 * g], oo[dblk][4 * g + 1], oo[dblk][4 * g + 2], oo[dblk][4 * g + 3]});
  }
}

constexpr int DIFF_BUF = 35840;
DI void diff_phase(char* smem, const Params& p, int j, float lam_init) {
  bf16_t* sK = (bf16_t*)smem;
  bf16_t* sVt = sK + 64 * 136;
  float* cbuf = (float*)smem;
  const int tid = otid(), lane = tid & 63, wid = tid >> 6, r = lane & 31, h = lane >> 5, mp = wid >> 2, qs = wid & 3;
  const int g4 = tid & 15, dg = (tid >> 4) & 15, t2 = tid & 255;
  const bool ldv = tid < 256, skew = wave_skew(wid);
  float lam;
  {
    const float* lf = p.ev_lambda + j * 256;
    float d01 = lf[lane] * lf[64 + lane], d23 = lf[128 + lane] * lf[192 + lane];
#pragma unroll
    for (int off = 32; off >= 1; off >>= 1) { d01 += __shfl_xor(d01, off); d23 += __shfl_xor(d23, off); }
    lam = expf(d01) - expf(d23) + lam_init;
  }
  const float* subln = p.ev_subln + j * 128;
  for (int rnd = 0; rnd * (int)gridDim.x < NB * 4 * 16; ++rnd) {
    const int it = rnd * (int)gridDim.x + ((rnd & 1) ? ((int)gridDim.x - 1 - obid()) : obid());
    if (it >= NB * 4 * 16) break;
    const int qt = 15 - it / (NB * 4), rem = it % (NB * 4), b = rem >> 2, hd = rem & 3;
    const int q0 = qt * 128 + qs * 32, tq = q0 + r;
    const bf16_t* yb = p.Y + (long)b * T * LDE;
    bf16x8 qf[4];
#pragma unroll
    for (int ks = 0; ks < 4; ++ks) qf[ks] = *(const bf16x8*)(yb + (long)tq * LDE + E_QB + hd * 128 + mp * 64 + ks * 16 + h * 8);
    FLASH_STATE(4)
    const int nkt = 2 * qt + 2;
    u32x4 st[4];
    auto issue = [&](int kt) {
      const bf16_t* base = yb + (long)(kt * 64) * LDE;
      if (ldv) {
#pragma unroll
        for (int i = 0; i < 4; ++i) st[i] = *(const u32x4*)(base + (long)(g4 * 4 + i) * LDE + E_VB + hd * 128 + dg * 8);
      } else {
#pragma unroll
        for (int i = 0; i < 4; ++i) { const int c = t2 + i * 256; st[i] = *(const u32x4*)(base + (long)(c >> 4) * LDE + E_KB + hd * 128 + (c & 15) * 8); }
      }
    };
    auto stash = [&](int buf) {
      bf16_t* bK = sK + buf * (DIFF_BUF / 2); bf16_t* bV = sVt + buf * (DIFF_BUF / 2);
      if (ldv) vt_write(bV, 72, dg * 8, vt_pos(g4), st);
      else {
#pragma unroll
        for (int i = 0; i < 4; ++i) { const int c = t2 + i * 256; *(u32x4*)(bK + (c >> 4) * 136 + (c & 15) * 8) = st[i]; }
      }
    };
    issue(0);
    __syncthreads();
    stash(0);
    issue(1);
    __syncthreads();
    u32x4 pw[4]; bool havep = false; int pbuf = 0;
    for (int kt = 0; kt < nkt; ++kt) {
      const int buf = kt % 3;
      const bf16_t* bK = sK + buf * (DIFF_BUF / 2) + mp * 64; const bf16_t* bV = sVt + buf * (DIFF_BUF / 2);
      if (skew && havep) { pv_tile<4>(o, pw, sVt + pbuf * (DIFF_BUF / 2), 72); havep = false; }
      if (kt * 64 + 63 <= q0) {
        qk_softmax<4, 4, 0>(pw, o, negref, mrun, l, qf, bK, 136, [&](int kb, int i) { return true; });
        if (skew) { havep = true; pbuf = buf; } else pv_tile<4>(o, pw, bV, 72);
      } else if (kt * 64 <= q0 + 31) {
        const int lim = tq - kt * 64 - 4 * h;
        qk_softmax<4, 4, 1>(pw, o, negref, mrun, l, qf, bK, 136, [&](int kb, int i) { return kb * 32 + (i & 3) + 8 * (i >> 2) <= lim; });
        if (skew) { havep = true; pbuf = buf; } else pv_tile<4>(o, pw, bV, 72);
      }
      if (kt + 1 < nkt) {
        stash((kt + 1) % 3);
        if (kt + 2 < nkt) issue(kt + 2);
        __syncthreads();
      }
    }
    if (skew && havep) pv_tile<4>(o, pw, sVt + pbuf * (DIFF_BUF / 2), 72);
    l += __shfl_xor(l, 32);
    const float inv = l > 0.f ? 1.0f / l : 0.f;
    __syncthreads();
    if (mp == 1) {
#pragma unroll
      for (int db = 0; db < 4; ++db)
#pragma unroll
        for (int g = 0; g < 4; ++g)
          *(f32x4*)(cbuf + (qs * 32 + r) * 132 + db * 32 + 8 * g + 4 * h) = (f32x4){o[db][4 * g] * inv, o[db][4 * g + 1] * inv, o[db][4 * g + 2] * inv, o[db][4 * g + 3] * inv};
    }
    __syncthreads();
    if (mp == 0) {
      float ss = 0.f;
#pragma unroll
      for (int db = 0; db < 4; ++db)
#pragma unroll
        for (int g = 0; g < 4; ++g) {
          const f32x4 o1 = *(const f32x4*)(cbuf + (qs * 32 + r) * 132 + db * 32 + 8 * g + 4 * h);
#pragma unroll
          for (int jj = 0; jj < 4; ++jj) { const float a = o[db][4 * g + jj] * inv - lam * o1[jj]; o[db][4 * g + jj] = a; ss += a * a; }
        }
      ss += __shfl_xor(ss, 32);
      const float rs = (1.0f - lam_init) / sqrtf(ss * (1.0f / 128.0f) + 1e-6f);
      bf16_t* orow = p.O + ((long)b * T + tq) * DM + 512 + hd * 128;
#pragma unroll
      for (int db = 0; db < 4; ++db)
#pragma unroll
        for (int g = 0; g < 4; ++g) {
          const f32x4 sg = *(const f32x4*)(subln + db * 32 + 8 * g + 4 * h);
          store_bf4(orow + db * 32 + 8 * g + 4 * h, (f32x4){o[db][4 * g] * rs * sg[0], o[db][4 * g + 1] * rs * sg[1], o[db][4 * g + 2] * rs * sg[2], o[db][4 * g + 3] * rs * sg[3]});
        }
    }
  }
}

template <int MODE>
DI void nsa_branch(f32x16 (&tot)[2], float gate, unsigned tiles, const bf16x8 (&qf)[4], bf16_t* sK, bf16_t* sVt, const bf16_t* yb, int koff, int voff, int q0, int tq, unsigned mysel) {
  const int tid = otid(), lane = tid & 63, h = lane >> 5;
  const int g4 = tid & 15, dg = (tid >> 4) & 7, t2 = tid & 255;
  const bool ldv = tid < 128, ldk = tid >= 256;
  FLASH_STATE(2)
  unsigned rem = tiles;
  if (rem == 0u) return;
  u32x4 stA[2], stB[2];
  const int g2 = tid & 31, dg2 = (tid >> 5) & 7;
  const int vpos = vt_pos(g2 >> 1) + (g2 & 1) * 2;
  auto pop = [&]() { int r = -1; if (rem) { r = __ffs((int)rem) - 1; rem &= rem - 1u; } return r; };
  auto issue = [&](int jj, u32x4 (&st)[2]) {
    const bf16_t* base = yb + (long)(jj * 64) * LDO;
    if (tid < 256) {
#pragma unroll
      for (int i = 0; i < 2; ++i) st[i] = *(const u32x4*)(base + (long)(g2 * 2 + i) * LDO + voff + dg2 * 8);
    } else {
#pragma unroll
      for (int i = 0; i < 2; ++i) { const int c = t2 + i * 256; st[i] = *(const u32x4*)(base + (long)(c >> 3) * LDO + koff + (c & 7) * 8); }
    }
  };
  auto stash = [&](int buf, const u32x4 (&st)[2]) {
    if (tid < 256) vt_write2(sVt + buf * 4608, 72, dg2 * 8, vpos, st);
    else {
#pragma unroll
      for (int i = 0; i < 2; ++i) { const int c = t2 + i * 256; *(u32x4*)(sK + buf * 4608 + (c >> 3) * 72 + (c & 7) * 8) = st[i]; }
    }
  };
  u32x4 pw[4]; bool havep = false; int pbuf = 0;
  const bool skew = wave_skew(tid >> 6);
  int buf = 0;
  int j0 = pop(), j1 = pop(), j2 = pop();
  auto tile_step = [&](u32x4 (&st)[2]) {
    const int j = j0;
    const bf16_t* bK = sK + buf * 4608; const bf16_t* bV = sVt + buf * 4608;
    const int lim = tq - j * 64 - 4 * h;
    if (skew && havep) { pv_tile<2>(o, pw, sVt + pbuf * 4608, 72); havep = false; }
    bool done = false;
    if (MODE == 0) {
      const bool selb = ((mysel >> j) & 1u) != 0u;
      const unsigned long long bal = __ballot(selb);
      if (j * 64 <= q0 + 31 && bal != 0ull) {
        if (j * 64 + 63 <= q0 && bal == ~0ull)
          qk_softmax<4, 2, 0>(pw, o, negref, mrun, l, qf, bK, 72, [&](int kb, int i) { return true; });
        else if (j * 64 + 63 <= q0)
          qk_softmax<4, 2, 2>(pw, o, negref, mrun, l, qf, bK, 72, [&](int kb, int i) { return true; }, selb);
        else
          qk_softmax<4, 2, 1>(pw, o, negref, mrun, l, qf, bK, 72, [&](int kb, int i) { return selb && (kb * 32 + (i & 3) + 8 * (i >> 2) <= lim); });
        done = true;
      }
    } else {
      if (j * 64 <= q0 + 31 && j * 64 + 63 > q0 - 512) {
        if (j * 64 + 63 <= q0 && j * 64 > q0 + 31 - 512)
          qk_softmax<4, 2, 0>(pw, o, negref, mrun, l, qf, bK, 72, [&](int kb, int i) { return true; });
        else
          qk_softmax<4, 2, 1>(pw, o, negref, mrun, l, qf, bK, 72, [&](int kb, int i) { const int kk = kb * 32 + (i & 3) + 8 * (i >> 2); return kk <= lim && kk > lim - 512; });
        done = true;
      }
    }
    if (done) { if (skew) { havep = true; pbuf = buf; } else pv_tile<2>(o, pw, bV, 72); }
    if (j1 >= 0) {
      const int nbuf = buf == 2 ? 0 : buf + 1;
      stash(nbuf, st);
      const int j3 = pop();
      if (j3 >= 0) issue(j3, st);
      __syncthreads();
      buf = nbuf;
      j0 = j1; j1 = j2; j2 = j3;
    } else j0 = -1;
  };
  issue(j0, stA);
  __syncthreads();
  stash(0, stA);
  if (j1 >= 0) issue(j1, stB);
  if (j2 >= 0) issue(j2, stA);
  __syncthreads();
  while (j0 >= 0) {
    tile_step(stB);
    if (j0 >= 0) tile_step(stA);
  }
  if (skew && havep) pv_tile<2>(o, pw, sVt + pbuf * 4608, 72);
  l += __shfl_xor(l, 32);
  const float inv = l > 0.f ? gate / l : 0.f;
#pragma unroll
  for (int db = 0; db < 2; ++db)
#pragma unroll
    for (int i = 0; i < 16; ++i) tot[db][i] += o[db][i] * inv;
}

DI void nsa_phase(char* smem, const Params& p) {
  bf16_t* sK = (bf16_t*)smem;
  bf16_t* sVt = (bf16_t*)(smem + 18432);
  float* impb = (float*)(smem + 35840);
  float* imps = (float*)(smem + 69632);
  unsigned* selm = (unsigned*)(smem + 78080);
  const int tid = otid(), lane = tid & 63, wid = tid >> 6, r = lane & 31, h = lane >> 5, hh = wid & 3, qs = wid >> 2;
  for (int rnd = 0; rnd * (int)gridDim.x < NB * 32 * 4; ++rnd) {
    const int it = rnd * (int)gridDim.x + ((rnd & 1) ? ((int)gridDim.x - 1 - obid()) : obid());
    if (it >= NB * 32 * 4) break;
    const int qt = 31 - it / (NB * 4), rem = it % (NB * 4), b = rem >> 2, g = rem & 3;
    const int head = g * 4 + hh, q0 = qt * 64 + qs * 32, tq = q0 + r;
    const long tok = (long)b * T + tq;
    const bf16_t* yb = p.Y + (long)b * T * LDO;
    bf16x8 qf[4];
#pragma unroll
    for (int ks = 0; ks < 4; ++ks) qf[ks] = *(const bf16x8*)(yb + (long)tq * LDO + O_Q + head * 64 + ks * 16 + h * 8);
    const float g0 = p.GATES[tok * 48 + head * 3 + 0], g1 = p.GATES[tok * 48 + head * 3 + 1], g2 = p.GATES[tok * 48 + head * 3 + 2];
    __syncthreads();
    {
#pragma unroll
      for (int i = 0; i < 2; ++i) {
        const int c = tid + i * 512, row = c >> 3, cc = (c & 7) * 8;
        *(u32x4*)(sK + row * 72 + cc) = *(const u32x4*)(p.KCMP + ((long)(b * 128 + row) * 4 + g) * 64 + cc);
      }
      if (tid < 256) {
        const int g4 = tid & 31, dg = tid >> 5;
        u32x4 vv[4];
#pragma unroll
        for (int i = 0; i < 4; ++i) vv[i] = *(const u32x4*)(p.VCMP + ((long)(b * 128 + g4 * 4 + i) * 4 + g) * 64 + dg * 8);
        vt_write(sVt, 136, dg * 8, vt_pos(g4), vv);
      }
    }
    __syncthreads();
    f32x16 tot[2];
    {
      f32x16 s[4];
#pragma unroll
      for (int kb = 0; kb < 4; ++kb) {
#pragma unroll
        for (int i = 0; i < 16; ++i) s[kb][i] = 0.f;
#pragma unroll
        for (int ks = 0; ks < 4; ++ks) { const bf16x8 a = *(const bf16x8*)(sK + (kb * 32 + r) * 72 + ks * 16 + h * 8); s[kb] = mfma32(a, qf[ks], s[kb]); }
      }
      const int nlim = (tq >= 31 ? ((tq - 31) >> 4) : -1) - 4 * h;
      float mx = NEG_INF;
#pragma unroll
      for (int kb = 0; kb < 4; ++kb)
#pragma unroll
        for (int i = 0; i < 16; ++i) { const bool v = kb * 32 + (i & 3) + 8 * (i >> 2) <= nlim; const float sv = v ? s[kb][i] : NEG_INF; s[kb][i] = sv; mx = fmaxf(mx, sv); }
      mx = fmaxf(mx, __shfl_xor(mx, 32));
      const float muse = (mx == NEG_INF) ? 0.f : mx;
      float ps = 0.f;
#pragma unroll
      for (int kb = 0; kb < 4; ++kb)
#pragma unroll
        for (int i = 0; i < 16; ++i) { const float pv = ex2(s[kb][i] - muse); s[kb][i] = pv; ps += pv; }
      ps += __shfl_xor(ps, 32);
      const float inv = ps > 0.f ? 1.0f / ps : 0.f;
#pragma unroll
      for (int kb = 0; kb < 4; ++kb)
#pragma unroll
        for (int i = 0; i < 16; ++i) s[kb][i] *= inv;
      float part[4][4], recv[4][4];
#pragma unroll
      for (int kb = 0; kb < 4; ++kb)
#pragma unroll
        for (int g8 = 0; g8 < 4; ++g8) {
          part[kb][g8] = (s[kb][4 * g8] + s[kb][4 * g8 + 1]) + (s[kb][4 * g8 + 2] + s[kb][4 * g8 + 3]);
          recv[kb][g8] = __shfl_xor(s[kb][4 * g8 + 3], 32);
        }
#pragma unroll
      for (int kb = 0; kb < 4; ++kb)
#pragma unroll
        for (int g8 = 0; g8 < 4; ++g8) {
          float prev;
          if (h == 1) prev = recv[kb][g8];
          else prev = (g8 > 0) ? recv[kb][g8 - 1] : (kb > 0 ? recv[kb - 1][3] : 0.f);
          impb[(hh * 64 + qs * 32 + r) * 33 + kb * 8 + 2 * g8 + h] = part[kb][g8] + prev;
        }
      f32x16 oc[2];
#pragma unroll
      for (int db = 0; db < 2; ++db)
#pragma unroll
        for (int i = 0; i < 16; ++i) oc[db][i] = 0.f;
#pragma unroll
      for (int kb = 0; kb < 4; ++kb)
#pragma unroll
        for (int s2 = 0; s2 < 2; ++s2) {
          u32x4 pw;
#pragma unroll
          for (int jj = 0; jj < 4; ++jj) pw[jj] = pk2(s[kb][8 * s2 + 2 * jj], s[kb][8 * s2 + 2 * jj + 1]);
          const bf16x8 pf = __builtin_bit_cast(bf16x8, pw);
#pragma unroll
          for (int db = 0; db < 2; ++db) {
            const bf16x8 a = *(const bf16x8*)(sVt + (db * 32 + r) * 136 + kb * 32 + s2 * 16 + h * 8);
            oc[db] = mfma32(a, pf, oc[db]);
          }
        }
#pragma unroll
      for (int db = 0; db < 2; ++db)
#pragma unroll
        for (int i = 0; i < 16; ++i) tot[db][i] = oc[db][i] * g0;
    }
    __syncthreads();
    {
      const int rr = tid >> 3, t = qt * 64 + rr, cur = t >> 6;
#pragma unroll
      for (int jj = 0; jj < 4; ++jj) {
        const int j = (tid & 7) * 4 + jj;
        float v = (impb[(0 * 64 + rr) * 33 + j] + impb[(1 * 64 + rr) * 33 + j]) + (impb[(2 * 64 + rr) * 33 + j] + impb[(3 * 64 + rr) * 33 + j]);
        const bool forced = (j == 0) || (j == cur) || (j == cur - 1);
        const bool adm = j * 64 <= t;
        v = forced ? __builtin_huge_valf() : v;
        v = adm ? v : NEG_INF;
        imps[rr * 33 + j] = v;
      }
    }
    __syncthreads();
    {
      const int rr = tid >> 3;
      unsigned bits = 0;
#pragma unroll
      for (int jj = 0; jj < 4; ++jj) {
        const int j = (tid & 7) * 4 + jj;
        const float v = imps[rr * 33 + j];
        int cnt = 0;
#pragma unroll 8
        for (int j2 = 0; j2 < 32; ++j2) { const float v2 = imps[rr * 33 + j2]; cnt += ((v2 > v) || (v2 == v && j2 < j)) ? 1 : 0; }
        if (cnt < 16) bits |= 1u << j;
      }
      bits |= __shfl_xor((int)bits, 1); bits |= __shfl_xor((int)bits, 2); bits |= __shfl_xor((int)bits, 4);
      if ((tid & 7) == 0) selm[rr] = bits;
    }
    __syncthreads();
    const unsigned mysel = selm[qs * 32 + r];
    unsigned U = selm[r] | selm[32 + r];
#pragma unroll
    for (int off = 1; off < 32; off <<= 1) U |= (unsigned)__shfl_xor((int)U, off);
    const int jmax = qt;
    const unsigned causal = (jmax >= 31) ? 0xffffffffu : ((1u << (jmax + 1)) - 1u);
    U &= causal;
    U = (unsigned)__builtin_amdgcn_readfirstlane((int)U);
    nsa_branch<0>(tot, g1, U, qf, (bf16_t*)smem, (bf16_t*)(smem + 27648), yb, O_KS + g * 64, O_VS + g * 64, q0, tq, mysel);
    const int jlo = (qt * 64 >= 511 ? (qt * 64 - 511) : 0) >> 6;
    const unsigned W = causal & ~((1u << jlo) - 1u);
    nsa_branch<1>(tot, g2, W, qf, (bf16_t*)smem, (bf16_t*)(smem + 27648), yb, O_KW + g * 64, O_VW + g * 64, q0, tq, 0u);
    bf16_t* orow = p.O + tok * 1024 + head * 64;
#pragma unroll
    for (int db = 0; db < 2; ++db)
#pragma unroll
      for (int gg = 0; gg < 4; ++gg)
        store_bf4(orow + db * 32 + 8 * gg + 4 * h, (f32x4){tot[db][4 * gg], tot[db][4 * gg + 1], tot[db][4 * gg + 2], tot[db][4 * gg + 3]});
  }
}

#define XB_TMO      128
#define XB_XCNT(j)  (256  + 64 * (j))
#define XB_XSUB(j)  (1280 + 64 * (j))
#define XB_XGEN(j)  (2304 + 64 * (j))
#define XB_TOP      3328
#define XB_TOPGEN   3392
#define XCD_BAR_WORDS 3456
#define XB_SPIN_CAP (1u << 18)
#define XLAS __attribute__((address_space(3)))

__device__ __forceinline__ unsigned xb_ld(unsigned* p)              { return __hip_atomic_load(p, __ATOMIC_RELAXED, __HIP_MEMORY_SCOPE_AGENT); }
__device__ __forceinline__ unsigned xb_add(unsigned* p, unsigned v) { return __hip_atomic_fetch_add(p, v, __ATOMIC_RELAXED, __HIP_MEMORY_SCOPE_AGENT); }
__device__ __forceinline__ unsigned xb_xcc_id() { return (unsigned)__builtin_amdgcn_s_getreg((3 << 11) | 20) & 0xFu; }
#define XB_SPIN(cond, bar) do { unsigned _sp = 0; while (cond) { __builtin_amdgcn_s_sleep(1); \
    if ((++_sp & 255u) == 0u) { if (xb_ld(&(bar)[XB_TMO])) break; if (_sp > XB_SPIN_CAP) { atomicAdd(&(bar)[XB_TMO], 1u); break; } } } } while (0)

struct XcdBarrier {
    unsigned* bar; unsigned x;
    volatile XLAS unsigned* st;
};

__device__ __forceinline__ XcdBarrier xcd_barrier_post(unsigned* bar, volatile XLAS unsigned* st) {
    XcdBarrier b; b.bar = bar; b.x = xb_xcc_id(); b.st = st;
    if (threadIdx.x == 0) (void)xb_add(&bar[XB_XCNT(b.x)], 1u);
    return b;
}
__device__ __forceinline__ void xcd_barrier_complete(unsigned* bar, unsigned x, unsigned& nloc, unsigned& nx) {
    const unsigned G = gridDim.x * gridDim.y * gridDim.z;
    unsigned sum, cnt, mine, sp = 0u;
    for (;;) {
        sum = 0u; cnt = 0u; mine = 0u;
#pragma unroll
        for (unsigned j = 0; j < 16; ++j) { const unsigned c = xb_ld(&bar[XB_XCNT(j)]); sum += c; cnt += (c > 0u) ? 1u : 0u; mine = (j == x) ? c : mine; }
        if (sum == G) break;
        __builtin_amdgcn_s_sleep(1);
        if ((++sp & 255u) == 0u) { if (xb_ld(&bar[XB_TMO])) break; if (sp > XB_SPIN_CAP) { atomicAdd(&bar[XB_TMO], 1u); break; } }
    }
    nloc = mine > 0u ? mine : 1u; nx = cnt > 0u ? cnt : 1u;
}

__device__ __forceinline__ void xcd_barrier(const XcdBarrier& b) {
    asm volatile("s_waitcnt vmcnt(0)" ::: "memory");
    __syncthreads();
    if (threadIdx.x == 0) {
        unsigned* bar = b.bar;
        __builtin_amdgcn_s_waitcnt(0);
        unsigned nloc = b.st[0], nx = b.st[1];
        if (nloc == 0u) { xcd_barrier_complete(bar, b.x, nloc, nx); b.st[0] = nloc; b.st[1] = nx; }
        const unsigned old = xb_add(&bar[XB_XSUB(b.x)], 1u);
        const unsigned gen = old / nloc;
        if (old + 1u == (gen + 1u) * nloc) {
            __builtin_amdgcn_fence(__ATOMIC_RELEASE, "agent");
            asm volatile("s_waitcnt vmcnt(0)" ::: "memory");
            const unsigned og = xb_add(&bar[XB_TOP], 1u);
            const unsigned tg = og / nx;
            if (og + 1u == (tg + 1u) * nx) xb_add(&bar[XB_TOPGEN], 1u);
            else XB_SPIN(xb_ld(&bar[XB_TOPGEN]) == tg, bar);
            __builtin_amdgcn_fence(__ATOMIC_ACQUIRE, "agent");
            xb_add(&bar[XB_XGEN(b.x)], 1u);
            asm volatile("s_waitcnt vmcnt(0)" ::: "memory");
        } else {
            XB_SPIN(xb_ld(&bar[XB_XGEN(b.x)]) == gen, bar);
            __builtin_amdgcn_fence(__ATOMIC_ACQUIRE, "agent");
            asm volatile("s_waitcnt vmcnt(0)" ::: "memory");
        }
    }
    __syncthreads();
}


constexpr int LDS_BYTES = 131072 + 4096 + 16;
__global__ void __launch_bounds__(512, 2) fwd_kernel(Params p) {
  cg::grid_group grid = cg::this_grid();
  extern __shared__ __attribute__((aligned(16))) unsigned char lds[];
  char* smem = (char*)lds;
  float* red = (float*)(lds + 131072);
  volatile XLAS unsigned* xst = (volatile XLAS unsigned*)(lds + 131072 + 4096);
  if (threadIdx.x == 0) { xst[0] = 0u; xst[1] = 0u; }
  __syncthreads();
  const XcdBarrier xbar = xcd_barrier_post(p.BAR, xst);
  if (p.out == nullptr) grid.sync();
  for (int rep = 0; rep < REP_PRO; ++rep) { prologue(smem, p); rmsnorm_phase<true>(p, p.x, p.norm_mix, p.H, nullptr); xcd_barrier(xbar); }
  if (blockIdx.x < 4 && threadIdx.x < 128) { float s = 0.f; for (int i = 0; i < 64; ++i) s += p.CBP[(blockIdx.x * 64 + i) * 128 + threadIdx.x]; p.CB[blockIdx.x * 128 + threadIdx.x] = s; }
  for (int r4 = 0; r4 < 40; ++r4) xcd_barrier(xbar);
  const float* xcur = p.x;
  for (int layer = 0; layer < 4; ++layer) {
    const int j = layer >> 1;
    bool mixed = false;
    if ((layer & 1) == 0) {
#if EN_EVEN
      mixed = true;
      if (layer != 0) { rmsnorm_phase<true>(p, xcur, p.norm_mix + layer * DM, p.H, nullptr);
      xcd_barrier(xbar); }
      for (int rep = 0; rep < REP_GEMM; ++rep) { big_gemm(lds, p.H, p.WE + (long)j * LDE * DM, LDE, DM, EpiEven{p.Y, p.IW, p.ev_kv_gain + j * 128, p.cos64, p.sin64, p.cos32, p.sin32, red});
      xcd_barrier(xbar); }
      for (int rep = 0; rep < REP_ATT; ++rep) {
#if EN_DSA
      for (int r2 = 0; r2 < REP_IDX; ++r2) idx_phase(smem, p);
#endif
#if EN_DIFF
      for (int r2 = 0; r2 < REP_DIFF; ++r2) diff_phase(smem, p, j, layer == 0 ? 0.2f : 0.47071301834358416f);
#else
      for (long i = (long)blockIdx.x * NTHR + threadIdx.x; i < (long)NTOK * 512; i += (long)gridDim.x * NTHR) p.O[(i >> 9) * DM + 512 + (i & 511)] = 0;
#endif
      xcd_barrier(xbar);
#if EN_DSA
      dsa_phase(smem, p, j);
#else
      for (long i = (long)blockIdx.x * NTHR + threadIdx.x; i < (long)NTOK * 512; i += (long)gridDim.x * NTHR) p.O[(i >> 9) * DM + (i & 511)] = 0;
#endif
      xcd_barrier(xbar);
      }
      big_gemm(lds, p.O, p.WEO + (long)j * DM * DM, DM, DM, EpiResid{xcur, p.out});
      xcd_barrier(xbar);
#endif
    } else {
#if EN_ODD
      mixed = true;
      rmsnorm_phase<true>(p, xcur, p.norm_mix + layer * DM, p.H, nullptr);
      xcd_barrier(xbar);
      for (int rep = 0; rep < REP_GEMM; ++rep) { big_gemm(lds, p.H, p.WO + (long)j * NODD * DM, NODD, DM, EpiOdd{p.Y, p.GATES, p.cos64, p.sin64});
      xcd_barrier(xbar); }
      cmp_phase(smem, p, j);
      xcd_barrier(xbar);
      for (int rep = 0; rep < REP_ATT; ++rep) { nsa_phase(smem, p);
      xcd_barrier(xbar); }
      big_gemm(lds, p.O, p.WOO + (long)j * DM * DM, DM, DM, EpiResid{xcur, p.out});
      xcd_barrier(xbar);
#endif
    }
    if (!mixed && layer == 0) {
      for (long i = (long)blockIdx.x * NTHR + threadIdx.x; i < (long)NTOK * DM / 4; i += (long)gridDim.x * NTHR) ((f32x4*)p.out)[i] = ((const f32x4*)p.x)[i];
      xcd_barrier(xbar);
    }
    xcur = p.out;
#if EN_FFN
    rmsnorm_phase<true>(p, xcur, p.norm_ffn + layer * DM, p.H, nullptr);
    xcd_barrier(xbar);
    for (int rep = 0; rep < REP_GEMM; ++rep) { big_gemm(lds, p.H, p.WGU + (long)layer * 2 * DFF * DM, 2 * DFF, DM, EpiSwiglu{p.Y});
    xcd_barrier(xbar); }
    big_gemm(lds, p.Y, p.WD + (long)layer * DM * DFF, DM, DFF, EpiResid{p.out, p.out});
    xcd_barrier(xbar);
#endif
  }
  rmsnorm_phase<false>(p, p.out, p.norm_final, nullptr, p.out);
}

extern "C" void kernel_launch(void* const* d_in, const int* in_sizes, int n_in, void* d_out, int out_size, void* d_ws, size_t ws_size, hipStream_t stream) {
  static int grid_blocks = 0;
  if (!grid_blocks) {
    int dev = 0, cus = 0, per_cu = 0;
    (void)hipGetDevice(&dev);
    (void)hipDeviceGetAttribute(&cus, hipDeviceAttributeMultiprocessorCount, dev);
    if (hipFuncSetAttribute((const void*)fwd_kernel, hipFuncAttributeMaxDynamicSharedMemorySize, LDS_BYTES) != hipSuccess) fprintf(stderr, "hipFuncSetAttribute failed\n");
    (void)hipOccupancyMaxActiveBlocksPerMultiprocessor(&per_cu, fwd_kernel, NTHR, LDS_BYTES);
    if (per_cu < 1) fprintf(stderr, "occupancy query says %d blocks per CU\n", per_cu);
    (void)hipGetLastError();
    grid_blocks = cus;
    if (grid_blocks > 256) grid_blocks = 256;
  }
  Params p{};
  const float* const* in = (const float* const*)d_in;
  p.x = in[0]; p.norm_mix = in[1]; p.norm_ffn = in[2]; p.norm_final = in[3]; p.ev_w_in = in[4]; p.ev_kv_gain = in[5]; p.ev_w_uk = in[6]; p.ev_w_uv = in[7];
  p.ev_lambda = in[8]; p.ev_subln = in[9]; p.ev_w_out = in[10]; p.od_w_in = in[11]; p.od_cmp_pe = in[12]; p.od_cmp_w1 = in[13]; p.od_cmp_w2 = in[14];
  p.od_w_out = in[15]; p.ffn_w_gate = in[16]; p.ffn_w_up = in[17]; p.ffn_w_down = in[18];
  p.out = (float*)d_out;
  char* w = (char*)d_ws; size_t off = 0;
  auto take = [&](size_t bytes) { char* r = w + off; off += (bytes + 255) & ~(size_t)255; return r; };
  p.WE = (bf16_t*)take((size_t)2 * LDE * DM * 2);
  p.WEO = (bf16_t*)take((size_t)2 * DM * DM * 2);
  p.WUVP = (bf16_t*)take((size_t)2 * 8 * 64 * 128 * 2);
  p.WUKT = (bf16_t*)take((size_t)2 * 8 * 128 * 64 * 2);
  p.WO = (bf16_t*)take((size_t)2 * NODD * DM * 2);
  p.WOO = (bf16_t*)take((size_t)2 * DM * DM * 2);
  p.WGU = (bf16_t*)take((size_t)4 * 2 * DFF * DM * 2);
  p.WD = (bf16_t*)take((size_t)4 * DM * DFF * 2);
  p.WC1 = (bf16_t*)take((size_t)4 * 128 * 2048 * 2);
  p.WC2 = (bf16_t*)take((size_t)4 * 128 * 128 * 2);
  p.CBP = (float*)take((size_t)4 * 64 * 128 * 4);
  p.CB = (float*)take((size_t)4 * 128 * 4);
  p.cos64 = (float*)take((size_t)T * 32 * 4); p.sin64 = (float*)take((size_t)T * 32 * 4);
  p.cos32 = (float*)take((size_t)T * 16 * 4); p.sin32 = (float*)take((size_t)T * 16 * 4);
  p.H = (bf16_t*)take((size_t)NTOK * DM * 2);
  p.Y = (bf16_t*)take((size_t)(NTOK + 64) * LDE * 2);
  p.O = (bf16_t*)take((size_t)NTOK * DM * 2);
  p.SEL = (u64*)take((size_t)NTOK * 32 * 8);
  p.IW = (float*)take((size_t)NTOK * 8 * 4);
  p.GATES = (float*)take((size_t)NTOK * 48 * 4);
  p.BAR = (unsigned*)take((size_t)XCD_BAR_WORDS * 4);
  p.SCR = (float*)p.H;
  p.CH = p.H; p.KCMP = p.H + (size_t)2 * 8192 * 128; p.VCMP = p.KCMP + (size_t)8192 * 64;
  if (off > ws_size) fprintf(stderr, "workspace too small: need %zu have %zu\n", off, ws_size);
  if (hipMemsetAsync(p.BAR, 0, (size_t)XCD_BAR_WORDS * 4, stream) != hipSuccess) fprintf(stderr, "memset of barrier words failed\n");
  void* args[] = {&p};
  hipError_t e = hipLaunchCooperativeKernel((void*)fwd_kernel, dim3(grid_blocks), dim3(NTHR), args, LDS_BYTES, stream);
  if (e != hipSuccess) fprintf(stderr, "cooperative launch failed: %s (grid %d)\n", hipGetErrorString(e), grid_blocks);
}
```

```cpp
#include <hip/hip_runtime.h>
#include <hip/hip_cooperative_groups.h>
#include <stdint.h>
#include <stdio.h>
namespace cg = cooperative_groups;

#ifndef EN_EVEN
#define EN_EVEN 1
#endif
#ifndef EN_ODD
#define EN_ODD 1
#endif
#ifndef EN_DSA
#define EN_DSA 1
#endif
#ifndef EN_DIFF
#define EN_DIFF 1
#endif
#ifndef EN_FFN
#define EN_FFN 1
#endif
#ifndef REP_ATT
#define REP_ATT 1
#endif
#ifndef REP_GEMM
#define REP_GEMM 1
#endif
#ifndef REP_IDX
#define REP_IDX 1
#endif
#ifndef REP_DIFF
#define REP_DIFF 1
#endif
#ifndef REP_PRO
#define REP_PRO 1
#endif

#define DI __device__ __forceinline__
typedef unsigned short bf16_t;
typedef short bf16x8 __attribute__((ext_vector_type(8)));
typedef float f32x2 __attribute__((ext_vector_type(2)));
typedef float f32x4 __attribute__((ext_vector_type(4)));
typedef float f32x16 __attribute__((ext_vector_type(16)));
typedef __bf16 bf16x2_t __attribute__((ext_vector_type(2)));
typedef unsigned u32x2 __attribute__((ext_vector_type(2)));
typedef unsigned u32x4 __attribute__((ext_vector_type(4)));
typedef unsigned long long u64;

constexpr int NTOK = 32768, T = 2048, NB = 16, DM = 1024, DFF = 2816;
constexpr int LDE = 3072, LDO = 2688, NODD = 2816, NTHR = 512;
constexpr int E_QNOPE = 0, E_QROPE = 512, E_CKV = 768, E_KROPE = 896, E_IQ = 928, E_IK = 1440, E_QB = 1504, E_KB = 2016, E_VB = 2528, E_IW = 3040;
constexpr int O_Q = 0, O_KC = 1024, O_VC = 1280, O_KS = 1536, O_VS = 1792, O_KW = 2048, O_VW = 2304, O_G = 2560;
constexpr float LOG2E = 1.4426950408889634f;
constexpr float NEG_INF = -__builtin_huge_valf();

struct Params {
  const float *x, *norm_mix, *norm_ffn, *norm_final, *ev_w_in, *ev_kv_gain, *ev_w_uk, *ev_w_uv, *ev_lambda, *ev_subln, *ev_w_out,
      *od_w_in, *od_cmp_pe, *od_cmp_w1, *od_cmp_w2, *od_w_out, *ffn_w_gate, *ffn_w_up, *ffn_w_down;
  float* out;
  bf16_t *WE, *WEO, *WO, *WOO, *WGU, *WD, *WC1, *WC2, *WUVP, *WUKT;
  float *CBP, *CB, *cos64, *sin64, *cos32, *sin32;
  bf16_t *H, *Y, *O;
  u64* SEL;
  float *IW, *GATES;
  float* SCR;
  bf16_t *CH, *KCMP, *VCMP;
  unsigned* BAR;
};

DI int otid() { int t = threadIdx.x; asm volatile("" : "+v"(t)); return t; }
DI int obid() { int b = blockIdx.x; asm volatile("" : "+s"(b)); return b; }
DI unsigned pk2(float a, float b) { f32x2 v = {a, b}; bf16x2_t r = __builtin_convertvector(v, bf16x2_t); return __builtin_bit_cast(unsigned, r); }
DI float bf2f(bf16_t v) { return __uint_as_float(((unsigned)v) << 16); }
DI float ex2(float x) { return __builtin_amdgcn_exp2f(x); }
DI f32x4 mfma16(bf16x8 a, bf16x8 b, f32x4 c) { return __builtin_amdgcn_mfma_f32_16x16x32_bf16(a, b, c, 0, 0, 0); }
DI f32x16 mfma32(bf16x8 a, bf16x8 b, f32x16 c) { return __builtin_amdgcn_mfma_f32_32x32x16_bf16(a, b, c, 0, 0, 0); }

DI void tconv(float* tile, const float* src, int sld, int c0, int n, int K, bf16_t* dst, int dld, int r0, int mode, int& base) {
  const int tid = otid(), lane = tid & 63, ch = lane & 7, c4i = lane >> 3;
  const int GW = gridDim.x * (NTHR / 64);
  const int ncg = (n + 31) >> 5, items = ncg * (K >> 6), n4 = n >> 2;
  int start = obid() * (NTHR / 64) + (tid >> 6) - base; if (start < 0) start += GW;
  for (int it = start; it < items; it += GW) {
    const int cg = it % ncg, ks = it / ncg, c4 = cg * 8 + c4i;
    if (c4 < n4) {
      const int cc0 = c4 * 4;
      const float* sp = src + (long)(ks * 64 + ch * 8) * sld + c0 + cc0;
      f32x4 v[8];
#pragma unroll
      for (int kk = 0; kk < 8; ++kk) v[kk] = *(const f32x4*)(sp + (long)kk * sld);
#pragma unroll
      for (int q = 0; q < 4; ++q) {
        const int cc = cc0 + q; int row = cc;
        if (mode == 1) row = (cc >> 4) * 32 + (cc & 15);
        else if (mode == 2) row = (cc >> 4) * 32 + 16 + (cc & 15);
        else if (mode == 3) row = (cc & ~63) + ((cc & 31) >> 4) * 32 + ((cc >> 5) & 1) * 16 + (cc & 15);
        u32x4 w; w[0] = pk2(v[0][q], v[1][q]); w[1] = pk2(v[2][q], v[3][q]); w[2] = pk2(v[4][q], v[5][q]); w[3] = pk2(v[6][q], v[7][q]);
        *(u32x4*)(dst + (long)(r0 + row) * dld + ks * 64 + ch * 8) = w;
      }
    }
  }
  base = (base + items) % GW;
}

DI void prologue(char* smem, const Params& p) {
  float* tile = (float*)smem;
  const int tid = otid(), G = gridDim.x, bid = obid();
  int base = 0;
  for (int l = 0; l < 4; ++l) {
    tconv(tile, p.ffn_w_gate + (long)l * DM * DFF, DFF, 0, DFF, DM, p.WGU + (long)l * 2 * DFF * DM, DM, 0, 1, base);
    tconv(tile, p.ffn_w_up + (long)l * DM * DFF, DFF, 0, DFF, DM, p.WGU + (long)l * 2 * DFF * DM, DM, 0, 2, base);
    tconv(tile, p.ffn_w_down + (long)l * DFF * DM, DM, 0, DM, DFF, p.WD + (long)l * DM * DFF, DFF, 0, 0, base);
  }
  for (int j = 0; j < 2; ++j) {
    const float* src = p.ev_w_in + (long)j * DM * 3048;
    bf16_t* dst = p.WE + (long)j * LDE * DM;
    tconv(tile, src, 3048, 0, 928, DM, dst, DM, 0, 0, base);
    tconv(tile, src, 3048, 928, 576, DM, dst, DM, E_IQ, 3, base);
    tconv(tile, src, 3048, 1504, 8, DM, dst, DM, E_IW, 0, base);
    tconv(tile, src, 3048, 1512, 1024, DM, dst, DM, E_QB, 3, base);
    tconv(tile, src, 3048, 2536, 512, DM, dst, DM, E_VB, 0, base);
    tconv(tile, p.ev_w_out + (long)j * DM * DM, DM, 0, DM, DM, p.WEO + (long)j * DM * DM, DM, 0, 0, base);
    {
      const float* so = p.od_w_in + (long)j * DM * 2608; bf16_t* dd = p.WO + (long)j * NODD * DM;
      tconv(tile, so, 2608, 0, 1280, DM, dd, DM, 0, 3, base);
      tconv(tile, so, 2608, 1280, 256, DM, dd, DM, 1280, 0, base);
      tconv(tile, so, 2608, 1536, 256, DM, dd, DM, 1536, 3, base);
      tconv(tile, so, 2608, 1792, 256, DM, dd, DM, 1792, 0, base);
      tconv(tile, so, 2608, 2048, 256, DM, dd, DM, 2048, 3, base);
      tconv(tile, so, 2608, 2304, 304, DM, dd, DM, 2304, 0, base);
    }
    tconv(tile, p.od_w_out + (long)j * DM * DM, DM, 0, DM, DM, p.WOO + (long)j * DM * DM, DM, 0, 0, base);
    for (int kv = 0; kv < 2; ++kv) {
      tconv(tile, p.od_cmp_w1 + (long)(j * 2 + kv) * 2048 * 128, 128, 0, 128, 2048, p.WC1 + (long)(j * 2 + kv) * 128 * 2048, 2048, 0, 0, base);
      tconv(tile, p.od_cmp_w2 + (long)(j * 2 + kv) * 128 * 64, 64, 0, 64, 128, p.WC2 + (long)(j * 2 + kv) * 128 * 128, 128, 0, 0, base);
    }
  }
  for (int idx = bid * NTHR + tid; idx < 2 * 8 * 128 * 64; idx += G * NTHR) {
    const int d = idx & 63, c = (idx >> 6) & 127, jh = idx >> 13;
    p.WUKT[idx] = (bf16_t)(pk2(p.ev_w_uk[((long)jh * 64 + d) * 128 + c], 0.f) & 0xffff);
  }
  for (int idx = bid * NTHR + tid; idx < 2 * 8 * 64 * 128; idx += G * NTHR) {
    const int pp = idx & 127, d = (idx >> 7) & 63, jh = idx >> 13;
    const int s = pp >> 4, hh = (pp >> 3) & 1, jj = pp & 7, c = 16 * s + 8 * (jj >> 2) + 4 * hh + (jj & 3);
    p.WUVP[idx] = (bf16_t)(pk2(p.ev_w_uv[((long)jh * 128 + c) * 64 + d], 0.f) & 0xffff);
  }
  for (int idx = bid * NTHR + tid; idx < T * 48; idx += G * NTHR) {
    const int pos = idx / 48, e = idx % 48;
    if (e < 32) {
      const float inv = (float)pow(10000.0, -(double)(2 * e) / 64.0);
      const float ang = (float)pos * inv;
      p.cos64[pos * 32 + e] = (float)cos((double)ang); p.sin64[pos * 32 + e] = (float)sin((double)ang);
    } else {
      const int i = e - 32;
      const float inv = (float)pow(10000.0, -(double)(2 * i) / 32.0);
      const float ang = (float)pos * inv;
      p.cos32[pos * 16 + i] = (float)cos((double)ang); p.sin32[pos * 16 + i] = (float)sin((double)ang);
    }
  }
  for (int it = bid; it < 4 * 16; it += G) {
    const int jk = it >> 4, ch = it & 15, c = tid & 127, q = tid >> 7;
    const float* pe = p.od_cmp_pe + (long)jk * 2048 + ch * 128 + q * 32;
    const float* w1 = p.od_cmp_w1 + ((long)jk * 2048 + ch * 128 + q * 32) * 128 + c;
    float s = 0.f;
#pragma unroll 8
    for (int f = 0; f < 32; ++f) s += pe[f] * w1[(long)f * 128];
    p.CBP[(jk * 64 + ch * 4 + q) * 128 + c] = s;
  }
}

template <bool TO_BF16>
DI void rmsnorm_phase(const Params& p, const float* xin, const float* gain, bf16_t* hout, float* fout) {
  const int lane = otid() & 63, wid = otid() >> 6;
  const int gw = obid() * 8 + wid, nw = gridDim.x * 8;
  f32x4 g[4];
#pragma unroll
  for (int i = 0; i < 4; ++i) g[i] = *(const f32x4*)(gain + i * 256 + lane * 4);
  for (int row = gw; row < NTOK; row += nw) {
    const float* xr = xin + (long)row * DM;
    f32x4 v[4]; float ss = 0.f;
#pragma unroll
    for (int i = 0; i < 4; ++i) { v[i] = *(const f32x4*)(xr + i * 256 + lane * 4); ss += v[i][0] * v[i][0] + v[i][1] * v[i][1] + v[i][2] * v[i][2] + v[i][3] * v[i][3]; }
#pragma unroll
    for (int off = 32; off >= 1; off >>= 1) ss += __shfl_xor(ss, off);
    const float rs = 1.0f / sqrtf(ss * (1.0f / DM) + 1e-6f);
#pragma unroll
    for (int i = 0; i < 4; ++i) {
      const f32x4 o = v[i] * rs * g[i];
      if (TO_BF16) { u32x2 w; w.x = pk2(o[0], o[1]); w.y = pk2(o[2], o[3]); *(u32x2*)(hout + (long)row * DM + i * 256 + lane * 4) = w; }
      else *(f32x4*)(fout + (long)row * DM + i * 256 + lane * 4) = o;
    }
  }
}

struct RowLinear { long ld; DI long operator()(int r) const { return (long)r * ld; } };
struct RowCmp { int off; DI long operator()(int r) const { const int g = r & 3, n = (r >> 2) & 127, b = r >> 9; return ((long)b * T + n * 16) * LDO + off + g * 64; } };
DI void store_bf4(bf16_t* dst, f32x4 v) { u32x2 w; w.x = pk2(v[0], v[1]); w.y = pk2(v[2], v[3]); *(u32x2*)dst = w; }

template <class RowMap, class Epi>
DI void gemm_tile128(char* smem, int tid, const bf16_t* A, RowMap rowmap, int a_kstep, const bf16_t* Bt, int ldb, int mt, int KT, Epi epi) {
  const int lane = tid & 63, wid = tid >> 6, wr = wid >> 1, wc = wid & 1, fr = lane & 15, fq = lane >> 4;
  bf16_t* sA = (bf16_t*)smem;
  bf16_t* sB = sA + 128 * 72;
  const bf16_t* ap[4]; const bf16_t* bp[4];
#pragma unroll
  for (int i = 0; i < 4; ++i) {
    const int c = tid + i * 256, r = c >> 3, cc = (c & 7) * 8;
    ap[i] = A + rowmap(mt * 128 + r) + cc;
    bp[i] = Bt + (long)r * ldb + cc;
  }
  f32x4 acc[4][4];
#pragma unroll
  for (int m = 0; m < 4; ++m)
#pragma unroll
    for (int n = 0; n < 4; ++n) acc[m][n] = (f32x4){0.f, 0.f, 0.f, 0.f};
  u32x4 ra[2][4], rb[2][4];
#pragma unroll
  for (int s = 0; s < 2; ++s)
    if (s < KT) {
#pragma unroll
      for (int i = 0; i < 4; ++i) { ra[s][i] = *(const u32x4*)(ap[i] + (long)s * a_kstep); rb[s][i] = *(const u32x4*)(bp[i] + s * 64); }
    }
  for (int kt3 = 0; kt3 < KT; kt3 += 2) {
#pragma unroll
    for (int s = 0; s < 2; ++s) {
      const int kt = kt3 + s;
      if (kt < KT) {
        __syncthreads();
#pragma unroll
        for (int i = 0; i < 4; ++i) {
          const int c = tid + i * 256, r = c >> 3, cc = (c & 7) * 8;
          *(u32x4*)(sA + r * 72 + cc) = ra[s][i];
          *(u32x4*)(sB + r * 72 + cc) = rb[s][i];
        }
        __syncthreads();
        if (kt + 2 < KT) {
#pragma unroll
          for (int i = 0; i < 4; ++i) { ra[s][i] = *(const u32x4*)(ap[i] + (long)(kt + 2) * a_kstep); rb[s][i] = *(const u32x4*)(bp[i] + (kt + 2) * 64); }
        }
#pragma unroll
        for (int ks = 0; ks < 2; ++ks) {
          bf16x8 af[4], bfr[4];
#pragma unroll
          for (int m = 0; m < 4; ++m) af[m] = *(const bf16x8*)(sA + (wr * 64 + m * 16 + fr) * 72 + ks * 32 + fq * 8);
#pragma unroll
          for (int n = 0; n < 4; ++n) bfr[n] = *(const bf16x8*)(sB + (wc * 64 + n * 16 + fr) * 72 + ks * 32 + fq * 8);
#pragma unroll
          for (int m = 0; m < 4; ++m)
#pragma unroll
            for (int n = 0; n < 4; ++n) acc[m][n] = mfma16(bfr[n], af[m], acc[m][n]);
        }
      }
    }
  }
  epi(acc, mt * 128 + wr * 64, wc * 64, lane);
}

struct EpiCmp1 {
  bf16_t* CH; const float* bias;
  DI void operator()(const f32x4 (&acc)[4][4], int row0, int col0, int lane) const {
    const int fr = lane & 15, fq = lane >> 4;
#pragma unroll
    for (int m = 0; m < 4; ++m)
#pragma unroll
      for (int n = 0; n < 4; ++n) {
        const f32x4 bv = *(const f32x4*)(bias + col0 + n * 16 + fq * 4);
        f32x4 o;
#pragma unroll
        for (int j = 0; j < 4; ++j) { const float x = acc[m][n][j] + bv[j]; o[j] = 0.5f * x * (1.0f + tanhf(0.7978845608028654f * (x + 0.044715f * x * x * x))); }
        store_bf4(CH + (long)(row0 + m * 16 + fr) * 128 + col0 + n * 16 + fq * 4, o);
      }
  }
};
struct EpiCmp2 {
  bf16_t* outp;
  DI void operator()(const f32x4 (&acc)[4][4], int row0, int col0, int lane) const {
    const int fr = lane & 15, fq = lane >> 4;
    if (col0 >= 64) return;
#pragma unroll
    for (int m = 0; m < 4; ++m) {
      const int row = row0 + m * 16 + fr;
      const bool dead = ((row >> 2) & 127) == 127;
#pragma unroll
      for (int n = 0; n < 4; ++n) store_bf4(outp + (long)row * 64 + col0 + n * 16 + fq * 4, dead ? (f32x4){0.f, 0.f, 0.f, 0.f} : acc[m][n]);
    }
  }
};

DI void cmp_phase(char* smem, const Params& p, int j) {
  const int t512 = otid(), half = t512 >> 8, tid = t512 & 255;
  if (obid() >= 64) return;
  const int tile = obid() * 2 + half, kv = tile >> 6, mt = tile & 63;
  char* sm = smem + half * 36864;
  if (kv == 0) gemm_tile128(sm, tid, p.Y, RowCmp{O_KC}, LDO, p.WC1 + (long)(j * 2 + 0) * 128 * 2048, 2048, mt, 32, EpiCmp1{p.CH, p.CB + (j * 2 + 0) * 128});
  else gemm_tile128(sm, tid, p.Y, RowCmp{O_VC}, LDO, p.WC1 + (long)(j * 2 + 1) * 128 * 2048, 2048, mt, 32, EpiCmp1{p.CH + 8192 * 128, p.CB + (j * 2 + 1) * 128});
  __threadfence();
  __syncthreads();
  if (kv == 0) gemm_tile128(sm, tid, p.CH, RowLinear{128}, 64, p.WC2 + (long)(j * 2 + 0) * 128 * 128, 128, mt, 2, EpiCmp2{p.KCMP});
  else gemm_tile128(sm, tid, p.CH + 8192 * 128, RowLinear{128}, 64, p.WC2 + (long)(j * 2 + 1) * 128 * 128, 128, mt, 2, EpiCmp2{p.VCMP});
}

namespace pg8 {
#define PG8_LAS __attribute__((address_space(3)))
constexpr int BM = 256, BK = 64, HALF = 128, HTB = HALF * BK * 2, STAGE_BYTES = 8 * HTB, NXCD = 8, WGM = 8;
__host__ __device__ __forceinline__ int lds_byte(int r, int c) { const int st = (r >> 4) * 2 + (c >> 5), rr = r & 15, cc = c & 31, ob = rr * 64 + cc * 2; return st * 1024 + (ob ^ (((ob >> 9) & 1) << 5)); }
__host__ __device__ __forceinline__ void stage_rc(int b, int& R, int& C) { const int st = b / 1024, sb = b % 1024, swz = sb ^ (((sb >> 9) & 1) << 5); R = (st >> 1) * 16 + swz / 64; C = (st & 1) * 32 + (swz % 64) / 2; }
__host__ __device__ __forceinline__ int perm32(int rho) { const int n = rho >> 4, i = rho & 15; return 8 * (i >> 2) + 4 * n + (i & 3); }
struct Unit { int pm, pn; };
struct Gemm { const bf16_t* A; const bf16_t* Bt; int M, N, K; };
struct StaticOrder {
    int nM, nN, nwg, G, c;
    __host__ __device__ void init(int M, int N, int G_, int c_) { nM = M / BM; nN = N / BM; nwg = nM * nN; G = G_; c = c_; }
    __host__ __device__ bool next(int i, Unit& u) const {
        const long L = (long)i * G + c; if (L >= nwg) return false;
        int wgid = (int)L; { const int q = nwg / NXCD, r = nwg % NXCD, xcd = wgid % NXCD, off = wgid / NXCD; wgid = (xcd < r ? xcd * (q + 1) : r * (q + 1) + (xcd - r) * q) + off; }
        const int nig = WGM * nN, gid = wgid / nig, fm = gid * WGM, gsz = (nM - fm) < WGM ? (nM - fm) : WGM;
        u.pm = fm + ((wgid % nig) % gsz); u.pn = (wgid % nig) / gsz; return true;
    }
    __device__ __forceinline__ void a_ready(const Unit&) const {}
    __device__ __forceinline__ void done(const Unit&) const {}
};
template <class Epi, class Sched, bool ALIGN_EPI = false, bool SP2 = false>
__device__ __forceinline__ void gemm_phase(PG8_LAS unsigned char* lds, const Gemm g, const Sched& S, const Epi& E) {
    const int tid = otid(), wid = __builtin_amdgcn_readfirstlane(tid >> 6), lane = tid & 63, wr = wid >> 2, wc = wid & 3, fr = lane & 15, fq = lane >> 4;
    const int K = g.K, nt = K / BK;
    unsigned voffA[2], voffB[2];
#pragma unroll
    for (int i = 0; i < 2; ++i) { int R, C; stage_rc(tid * 16 + i * 8192, R, C); const int Rb = Epi::PERM ? ((R & ~31) + perm32(R & 31)) : R;
        voffA[i] = (unsigned)(R * K + C) * 2u; voffB[i] = (unsigned)(Rb * K + C) * 2u; }
    const size_t kstep = (size_t)(BK * 2);
    const size_t hstep = (size_t)HALF * K * 2;
    const size_t tstep = 2 * hstep;
    const unsigned ldsw = (unsigned)wid * 1024u;
    const int aoff = lds_byte(wr * 64 + fr, fq * 8), boff = lds_byte(wc * 32 + fr, fq * 8);
#define PG8_SA(b, h) (((b) * 2 + (h)) * HTB)
#define PG8_SB(b, h) ((4 + (b) * 2 + (h)) * HTB)
#define PG8_STAGE(bufoff, gbase, voff) do { _Pragma("unroll") for (int _i = 0; _i < 2; ++_i) \
        __builtin_amdgcn_global_load_lds((const unsigned*)((const char*)(gbase) + (voff)[_i]), (PG8_LAS unsigned*)(lds + (bufoff) + ldsw + _i * 8192), 16, 0, 0); } while (0)
#define PG8_LDA(dst, b, h) do { _Pragma("unroll") for (int m = 0; m < 4; ++m) _Pragma("unroll") for (int k = 0; k < 2; ++k) dst[m][k] = *(const PG8_LAS bf16x8*)(lds + PG8_SA(b, h) + aoff + m * 2048 + k * 1024); } while (0)
#define PG8_LDB(dst, b, h) do { _Pragma("unroll") for (int n = 0; n < 2; ++n) _Pragma("unroll") for (int k = 0; k < 2; ++k) dst[n][k] = *(const PG8_LAS bf16x8*)(lds + PG8_SB(b, h) + boff + n * 2048 + k * 1024); } while (0)
#define PG8_MMA(ai, bj, At, Bt) do { __builtin_amdgcn_s_setprio(1); _Pragma("unroll") for (int m = 0; m < 4; ++m) _Pragma("unroll") for (int n = 0; n < 2; ++n) _Pragma("unroll") for (int k = 0; k < 2; ++k) \
        acc[ai][bj][m][n] = __builtin_amdgcn_mfma_f32_16x16x32_bf16(Bt[n][k], At[m][k], acc[ai][bj][m][n], 0, 0, 0); __builtin_amdgcn_s_setprio(0); } while (0)
#define PG8_WAIT_V(n) asm volatile("s_waitcnt vmcnt(" #n ")" ::: "memory")
#define PG8_WAIT_L(n) asm volatile("s_waitcnt lgkmcnt(" #n ")" ::: "memory")
#define PG8_BAR __builtin_amdgcn_s_barrier()
#define PG8_SCHED __builtin_amdgcn_sched_barrier(0)
    Unit cur, nxt; int ui = 0;
    if (!S.next(0, cur)) return;
    f32x4 acc[2][2][4][2];
#pragma unroll
    for (int a = 0; a < 2; ++a)
#pragma unroll
        for (int b = 0; b < 2; ++b)
#pragma unroll
            for (int m = 0; m < 4; ++m)
#pragma unroll
                for (int n = 0; n < 2; ++n) acc[a][b][m][n] = (f32x4){0.f, 0.f, 0.f, 0.f};
    bf16x8 At[4][2], B0[2][2], B1[2][2];
    const char* cA = (const char*)g.A + (size_t)cur.pm * tstep; const char* cB = (const char*)g.Bt + (size_t)cur.pn * tstep;
    S.a_ready(cur);
    if constexpr (SP2) {
        PG8_STAGE(PG8_SB(0, 0), cB, voffB); PG8_STAGE(PG8_SB(0, 1), cB + hstep, voffB); PG8_STAGE(PG8_SA(0, 0), cA, voffA); PG8_STAGE(PG8_SA(0, 1), cA + hstep, voffA);
        if (wr == 1) PG8_BAR;
        PG8_WAIT_V(2); PG8_BAR;
        PG8_STAGE(PG8_SB(1, 0), cB + kstep, voffB); PG8_STAGE(PG8_SA(1, 0), cA + kstep, voffA); PG8_STAGE(PG8_SB(1, 1), cB + hstep + kstep, voffB);
        PG8_WAIT_V(6); PG8_BAR;
    } else {
        PG8_STAGE(PG8_SB(0, 0), cB, voffB); PG8_STAGE(PG8_SA(0, 0), cA, voffA); PG8_STAGE(PG8_SB(0, 1), cB + hstep, voffB); PG8_STAGE(PG8_SA(0, 1), cA + hstep, voffA);
        if (wr == 1) PG8_BAR;
        PG8_WAIT_V(4); PG8_BAR;
        PG8_STAGE(PG8_SB(1, 0), cB + kstep, voffB); PG8_STAGE(PG8_SA(1, 0), cA + kstep, voffA); PG8_STAGE(PG8_SB(1, 1), cB + hstep + kstep, voffB);
        PG8_WAIT_V(6); PG8_BAR;
    }
    for (;;) {
        const bool has_next = S.next(ui + 1, nxt);
        const char* nA = has_next ? (const char*)g.A + (size_t)nxt.pm * tstep : cA; const char* nB = has_next ? (const char*)g.Bt + (size_t)nxt.pn * tstep : cB;
        for (int t = 0; t < nt; t += 2) {
            const bool last = (t == nt - 2);
            const char* a1 = cA + (size_t)(t + 1) * kstep;
            const char* a2 = last ? nA : cA + (size_t)(t + 2) * kstep; const char* b2 = last ? nB : cB + (size_t)(t + 2) * kstep;
            const char* a3 = a2 + kstep; const char* b3 = b2 + kstep;
            if (last && has_next) S.a_ready(nxt);
            if constexpr (SP2) {
            PG8_LDB(B0, 0, 0); PG8_LDB(B1, 0, 1); PG8_SCHED; PG8_LDA(At, 0, 0); PG8_STAGE(PG8_SA(1, 1), a1 + hstep, voffA);
            PG8_WAIT_V(8); PG8_WAIT_L(0); PG8_BAR; PG8_MMA(0, 0, At, B0); PG8_MMA(0, 1, At, B1); PG8_BAR; PG8_SCHED;
            PG8_LDA(At, 0, 1); PG8_STAGE(PG8_SB(0, 0), b2, voffB); PG8_STAGE(PG8_SB(0, 1), b2 + hstep, voffB); PG8_STAGE(PG8_SA(0, 0), a2, voffA);
            PG8_WAIT_V(8); PG8_WAIT_L(0); PG8_BAR; PG8_MMA(1, 0, At, B0); PG8_MMA(1, 1, At, B1); PG8_BAR; PG8_SCHED;
            PG8_LDB(B0, 1, 0); PG8_LDB(B1, 1, 1); PG8_SCHED; PG8_LDA(At, 1, 0); PG8_STAGE(PG8_SA(0, 1), a2 + hstep, voffA);
            PG8_WAIT_V(8); PG8_WAIT_L(0); PG8_BAR; PG8_MMA(0, 0, At, B0); PG8_MMA(0, 1, At, B1); PG8_BAR; PG8_SCHED;
            PG8_LDA(At, 1, 1); PG8_STAGE(PG8_SB(1, 0), b3, voffB); PG8_STAGE(PG8_SB(1, 1), b3 + hstep, voffB); PG8_STAGE(PG8_SA(1, 0), a3, voffA);
            PG8_WAIT_V(8); PG8_WAIT_L(0); PG8_BAR; PG8_MMA(1, 0, At, B0); PG8_MMA(1, 1, At, B1); PG8_BAR; PG8_SCHED;
            } else {
            PG8_LDB(B0, 0, 0); PG8_SCHED; PG8_LDA(At, 0, 0); PG8_STAGE(PG8_SA(1, 1), a1 + hstep, voffA);
            PG8_WAIT_L(8); PG8_BAR; PG8_WAIT_L(0); PG8_MMA(0, 0, At, B0); PG8_BAR; PG8_SCHED;
            PG8_LDB(B1, 0, 1); PG8_STAGE(PG8_SB(0, 0), b2, voffB);
            PG8_BAR; PG8_WAIT_L(0); PG8_MMA(0, 1, At, B1); PG8_BAR;
            PG8_LDA(At, 0, 1); PG8_STAGE(PG8_SA(0, 0), a2, voffA);
            PG8_BAR; PG8_WAIT_L(0); PG8_MMA(1, 0, At, B0); PG8_BAR; PG8_SCHED;
            PG8_STAGE(PG8_SB(0, 1), b2 + hstep, voffB);
            PG8_WAIT_V(6); PG8_BAR; PG8_MMA(1, 1, At, B1); PG8_BAR;
            PG8_LDB(B0, 1, 0); PG8_SCHED; PG8_LDA(At, 1, 0); PG8_STAGE(PG8_SA(0, 1), a2 + hstep, voffA);
            PG8_WAIT_L(8); PG8_BAR; PG8_WAIT_L(0); PG8_MMA(0, 0, At, B0); PG8_BAR; PG8_SCHED;
            PG8_LDB(B1, 1, 1); PG8_STAGE(PG8_SB(1, 0), b3, voffB);
            PG8_BAR; PG8_WAIT_L(0); PG8_MMA(0, 1, At, B1); PG8_BAR;
            PG8_LDA(At, 1, 1); PG8_STAGE(PG8_SA(1, 0), a3, voffA);
            PG8_BAR; PG8_WAIT_L(0); PG8_MMA(1, 0, At, B0); PG8_BAR; PG8_SCHED;
            PG8_STAGE(PG8_SB(1, 1), b3 + hstep, voffB);
            PG8_WAIT_V(6); PG8_BAR; PG8_MMA(1, 1, At, B1); PG8_BAR;
            }
        }
        if constexpr (ALIGN_EPI) { if (wr == 0) PG8_BAR; }
        if constexpr (!Epi::AFTER_DRAIN) { E(acc, cur, wr, wc, fr, fq); S.done(cur); }
        if (!has_next) break;
#pragma unroll
        for (int a = 0; a < 2; ++a)
#pragma unroll
            for (int b = 0; b < 2; ++b)
#pragma unroll
                for (int m = 0; m < 4; ++m)
#pragma unroll
                    for (int n = 0; n < 2; ++n) acc[a][b][m][n] = (f32x4){0.f, 0.f, 0.f, 0.f};
        cur = nxt; cA = nA; cB = nB; ++ui;
        if constexpr (ALIGN_EPI) { if (wr == 1) PG8_BAR; }
    }
    PG8_WAIT_V(0);
    if constexpr (!ALIGN_EPI) { if (wr == 0) PG8_BAR; }
    PG8_BAR;
    if constexpr (Epi::AFTER_DRAIN) { E.fused(acc, cur, wr, wc, fr, fq, lds, wid, lane); S.done(cur); }
#undef PG8_SA
#undef PG8_SB
#undef PG8_STAGE
#undef PG8_LDA
#undef PG8_LDB
#undef PG8_MMA
#undef PG8_WAIT_V
#undef PG8_WAIT_L
#undef PG8_BAR
#undef PG8_SCHED
}
}

struct EpiResid {
  static constexpr bool PERM = false, AFTER_DRAIN = false;
  const float* xin; float* xout;
  DI void operator()(const f32x4 (&acc)[2][2][4][2], const pg8::Unit& u, int wr, int wc, int fr_, int fq_) const {
    int fr = fr_, fq = fq_; asm volatile("" : "+v"(fr), "+v"(fq));
#pragma unroll
    for (int ai = 0; ai < 2; ++ai)
#pragma unroll
      for (int m = 0; m < 4; ++m) {
        const long rowoff = (long)(u.pm * 256 + ai * 128 + wr * 64 + m * 16 + fr) * DM + u.pn * 256 + wc * 32 + fq * 4;
#pragma unroll
        for (int bj = 0; bj < 2; ++bj)
#pragma unroll
          for (int n = 0; n < 2; ++n) {
            const long off = rowoff + bj * 128 + n * 16;
            *(f32x4*)(xout + off) = *(const f32x4*)(xin + off) + acc[ai][bj][m][n];
          }
      }
  }
};

struct EpiSwiglu {
  static constexpr bool PERM = false, AFTER_DRAIN = false;
  bf16_t* hid;
  DI void operator()(const f32x4 (&acc)[2][2][4][2], const pg8::Unit& u, int wr, int wc, int fr_, int fq_) const {
    int fr = fr_, fq = fq_; asm volatile("" : "+v"(fr), "+v"(fq));
#pragma unroll
    for (int ai = 0; ai < 2; ++ai)
#pragma unroll
      for (int m = 0; m < 4; ++m) {
        bf16_t* rowp = hid + (long)(u.pm * 256 + ai * 128 + wr * 64 + m * 16 + fr) * DFF + u.pn * 128 + wc * 16 + fq * 4;
#pragma unroll
        for (int bj = 0; bj < 2; ++bj) {
          f32x4 o;
#pragma unroll
          for (int j = 0; j < 4; ++j) { const float g = acc[ai][bj][m][0][j], uu = acc[ai][bj][m][1][j]; o[j] = g / (1.0f + __expf(-g)) * uu; }
          store_bf4(rowp + bj * 64, o);
        }
      }
  }
};

constexpr float QS_A = 0.10206207261596577f * LOG2E;
constexpr float QS_8 = 0.125f * LOG2E;

DI void rope_pair_store(bf16_t* d1, bf16_t* d2, f32x4 x1, f32x4 x2, const float* cosr, const float* sinr, float sc) {
  const f32x4 cs = *(const f32x4*)cosr, sn = *(const f32x4*)sinr;
  store_bf4(d1, (x1 * cs - x2 * sn) * sc);
  store_bf4(d2, (x2 * cs + x1 * sn) * sc);
}

struct EpiEven {
  static constexpr bool PERM = false, AFTER_DRAIN = false;
  bf16_t* Y; float* IW; const float* kv_gain; const float *cos64, *sin64, *cos32, *sin32; float* red;
  DI void operator()(const f32x4 (&acc)[2][2][4][2], const pg8::Unit& u, int wr, int wc, int fr_, int fq_) const {
    int fr = fr_, fq = fq_; asm volatile("" : "+v"(fr), "+v"(fq));
    if (u.pn == 3) {
#pragma unroll
      for (int ai = 0; ai < 2; ++ai)
#pragma unroll
        for (int m = 0; m < 4; ++m) {
          float ss = 0.f;
#pragma unroll
          for (int n = 0; n < 2; ++n)
#pragma unroll
            for (int j = 0; j < 4; ++j) ss += acc[ai][0][m][n][j] * acc[ai][0][m][n][j];
          ss += __shfl_xor(ss, 16); ss += __shfl_xor(ss, 32);
          if (fq == 0) red[wc * 256 + ai * 128 + wr * 64 + m * 16 + fr] = ss;
        }
      asm volatile("s_waitcnt lgkmcnt(0)" ::: "memory"); __builtin_amdgcn_s_barrier(); asm volatile("" ::: "memory");
#pragma unroll
      for (int ai = 0; ai < 2; ++ai)
#pragma unroll
        for (int m = 0; m < 4; ++m) {
          const int rl = ai * 128 + wr * 64 + m * 16 + fr;
          const float tot = (red[rl] + red[256 + rl]) + (red[512 + rl] + red[768 + rl]);
          const float rs = 1.0f / sqrtf(tot * (1.0f / 128.0f) + 1e-6f);
          bf16_t* dst = Y + (long)(u.pm * 256 + rl) * LDE + E_CKV + wc * 32 + fq * 4;
#pragma unroll
          for (int n = 0; n < 2; ++n) {
            const f32x4 gn = *(const f32x4*)(kv_gain + wc * 32 + n * 16 + fq * 4);
            store_bf4(dst + n * 16, acc[ai][0][m][n] * rs * gn);
          }
        }
    }
#pragma unroll
    for (int bj = 0; bj < 2; ++bj) {
      const int nc = u.pn * 256 + bj * 128 + wc * 32;
      if (nc >= E_CKV && nc < E_KROPE) continue;
#pragma unroll
      for (int ai = 0; ai < 2; ++ai)
#pragma unroll
        for (int m = 0; m < 4; ++m) {
          const int row = u.pm * 256 + ai * 128 + wr * 64 + m * 16 + fr, pos = row & (T - 1);
          bf16_t* yr = Y + (long)row * LDE;
          const f32x4 x1 = acc[ai][bj][m][0], x2 = acc[ai][bj][m][1];
          if (nc < E_QROPE) {
            store_bf4(yr + nc + fq * 4, x1); store_bf4(yr + nc + 16 + fq * 4, x2);
          } else if (nc < E_CKV) {
            rope_pair_store(yr + nc + fq * 4, yr + nc + 16 + fq * 4, x1, x2, cos32 + pos * 16 + fq * 4, sin32 + pos * 16 + fq * 4, QS_A);
          } else if (nc == E_KROPE) {
            rope_pair_store(yr + nc + fq * 4, yr + nc + 16 + fq * 4, x1, x2, cos32 + pos * 16 + fq * 4, sin32 + pos * 16 + fq * 4, 1.0f);
          } else if (nc < E_VB) {
            const int s0 = nc < E_QB ? E_IQ : E_QB, rel = nc - s0, hb = s0 + (rel & ~63), i0 = ((rel >> 5) & 1) * 16 + fq * 4;
            const float sc = (nc >= E_QB && nc < E_KB) ? QS_8 : 1.0f;
            rope_pair_store(yr + hb + i0, yr + hb + 32 + i0, x1, x2, cos64 + pos * 32 + i0, sin64 + pos * 32 + i0, sc);
          } else if (nc < E_IW) {
            store_bf4(yr + nc + fq * 4, x1); store_bf4(yr + nc + 16 + fq * 4, x2);
          } else {
            if (fq < 2) *(f32x4*)(IW + (long)row * 8 + fq * 4) = x1 * 0.35355339059327373f;
          }
          asm volatile("" ::: "memory");
        }
    }
  }
};

struct EpiOdd {
  static constexpr bool PERM = false, AFTER_DRAIN = false;
  bf16_t* Y; float* GATES; const float *cos64, *sin64;
  DI void operator()(const f32x4 (&acc)[2][2][4][2], const pg8::Unit& u, int wr, int wc, int fr_, int fq_) const {
    int fr = fr_, fq = fq_; asm volatile("" : "+v"(fr), "+v"(fq));
#pragma unroll
    for (int bj = 0; bj < 2; ++bj) {
      const int nc = u.pn * 256 + bj * 128 + wc * 32;
      if (nc >= 2624) continue;
#pragma unroll
      for (int ai = 0; ai < 2; ++ai)
#pragma unroll
        for (int m = 0; m < 4; ++m) {
          const int row = u.pm * 256 + ai * 128 + wr * 64 + m * 16 + fr, pos = row & (T - 1);
          bf16_t* yr = Y + (long)row * LDO;
          const f32x4 x1 = acc[ai][bj][m][0], x2 = acc[ai][bj][m][1];
          const int sec = nc < O_KC ? 0 : ((nc - O_KC) >> 8);
          if (nc < O_KC || (nc < O_G && (sec & 1) == 0)) {
            const int hb = nc & ~63, i0 = ((nc >> 5) & 1) * 16 + fq * 4;
            rope_pair_store(yr + hb + i0, yr + hb + 32 + i0, x1, x2, cos64 + pos * 32 + i0, sin64 + pos * 32 + i0, nc < O_KC ? QS_8 : 1.0f);
          } else if (nc < O_G) {
            store_bf4(yr + nc + fq * 4, x1); store_bf4(yr + nc + 16 + fq * 4, x2);
          } else {
            const int gc = nc - O_G;
            f32x4 o;
#pragma unroll
            for (int j = 0; j < 4; ++j) o[j] = 1.0f / (1.0f + __expf(-x1[j]));
            *(f32x4*)(GATES + (long)row * 48 + gc + fq * 4) = o;
            if (gc == 0) {
#pragma unroll
              for (int j = 0; j < 4; ++j) o[j] = 1.0f / (1.0f + __expf(-x2[j]));
              *(f32x4*)(GATES + (long)row * 48 + 16 + fq * 4) = o;
            }
          }
          asm volatile("" ::: "memory");
        }
    }
  }
};

template <class Epi>
DI void big_gemm(unsigned char* lds, const bf16_t* A, const bf16_t* Bt, int N, int K, const Epi& E) {
  pg8::Gemm g{A, Bt, NTOK, N, K};
  pg8::StaticOrder S; S.init(NTOK, N, (int)gridDim.x, obid());
  pg8::gemm_phase<Epi, pg8::StaticOrder, true, true>((PG8_LAS unsigned char*)lds, g, S, E);
}

DI int crow(int i, int h) { return (i & 3) + 8 * (i >> 2) + 4 * h; }
DI int vt_pos(int g4) { const int gi = g4 & 3; return (g4 >> 2) * 16 + (gi & 1) * 8 + (gi >> 1) * 4; }
DI void vt_write(bf16_t* sVt, int vst, int d0, int pos, const u32x4 (&kv)[4]) {
#pragma unroll
  for (int w = 0; w < 4; ++w) {
    u32x2 lo, hi;
    lo.x = (kv[0][w] & 0xffffu) | (kv[1][w] << 16); lo.y = (kv[2][w] & 0xffffu) | (kv[3][w] << 16);
    hi.x = (kv[0][w] >> 16) | (kv[1][w] & 0xffff0000u); hi.y = (kv[2][w] >> 16) | (kv[3][w] & 0xffff0000u);
    *(u32x2*)(sVt + (d0 + 2 * w) * vst + pos) = lo;
    *(u32x2*)(sVt + (d0 + 2 * w + 1) * vst + pos) = hi;
  }
}

DI void vt_write2(bf16_t* sVt, int vst, int d0, int pos, const u32x4 (&kv)[2]) {
#pragma unroll
  for (int w = 0; w < 4; ++w) {
    const unsigned lo = (kv[0][w] & 0xffffu) | (kv[1][w] << 16);
    const unsigned hi = (kv[0][w] >> 16) | (kv[1][w] & 0xffff0000u);
    *(unsigned*)(sVt + (d0 + 2 * w) * vst + pos) = lo;
    *(unsigned*)(sVt + (d0 + 2 * w + 1) * vst + pos) = hi;
  }
}
template <int NKS, int NDB, bool MASKED, class VF>
DI void flash_tile(f32x16 (&o)[NDB], f32x16& negref, float& mrun, float& l, const bf16x8 (&qf)[NKS], const bf16_t* sK, int kst, const bf16_t* sVt, int vst, VF valid) {
  const int lane = otid() & 63, r = lane & 31, h = lane >> 5;
  f32x16 s[2];
#pragma unroll
  for (int kb = 0; kb < 2; ++kb) {
#pragma unroll
    for (int ks = 0; ks < NKS; ++ks) {
      const bf16x8 a = *(const bf16x8*)(sK + (kb * 32 + r) * kst + ks * 16 + h * 8);
      if (ks == 0) s[kb] = mfma32(a, qf[0], negref); else s[kb] = mfma32(a, qf[ks], s[kb]);
    }
    __builtin_amdgcn_sched_barrier(0);
  }
  float mx = NEG_INF;
#pragma unroll
  for (int kb = 0; kb < 2; ++kb)
#pragma unroll
    for (int i = 0; i < 16; ++i) {
      if (MASKED) { const float sv = valid(kb, i) ? s[kb][i] : NEG_INF; s[kb][i] = sv; }
      mx = fmaxf(mx, s[kb][i]);
    }
  mx = fmaxf(mx, __shfl_xor(mx, 32));
  float mr = fmaxf(mrun, mx);
  const bool need = (mr > 8.0f) || (mr < -8.0f && mr != NEG_INF);
  if (__ballot(need) != 0ull) {
    const float delta = need ? mr : 0.f;
    const float alpha = ex2(-delta);
#pragma unroll
    for (int kb = 0; kb < 2; ++kb)
#pragma unroll
      for (int i = 0; i < 16; ++i) s[kb][i] -= delta;
#pragma unroll
    for (int db = 0; db < NDB; ++db)
#pragma unroll
      for (int i = 0; i < 16; ++i) o[db][i] *= alpha;
#pragma unroll
    for (int i = 0; i < 16; ++i) negref[i] -= delta;
    l *= alpha;
    mr -= delta;
  }
  mrun = mr;
  float ps = 0.f;
#pragma unroll
  for (int kb = 0; kb < 2; ++kb)
#pragma unroll
    for (int i = 0; i < 16; ++i) { const float pv = ex2(s[kb][i]); s[kb][i] = pv; ps += pv; }
  l += ps;
  __builtin_amdgcn_sched_barrier(0);
#pragma unroll
  for (int kb = 0; kb < 2; ++kb)
#pragma unroll
    for (int s2 = 0; s2 < 2; ++s2) {
      u32x4 pw;
#pragma unroll
      for (int jj = 0; jj < 4; ++jj) pw[jj] = pk2(s[kb][8 * s2 + 2 * jj], s[kb][8 * s2 + 2 * jj + 1]);
      const bf16x8 pf = __builtin_bit_cast(bf16x8, pw);
#pragma unroll
      for (int db = 0; db < NDB; ++db) {
        const bf16x8 a = *(const bf16x8*)(sVt + (db * 32 + r) * vst + kb * 32 + s2 * 16 + h * 8);
        o[db] = mfma32(a, pf, o[db]);
      }
      __builtin_amdgcn_sched_barrier(0);
    }
}
template <int NKS, int NDB, int MASKED, class VF, bool REFC = true>
DI void qk_softmax(u32x4 (&pw)[4], f32x16 (&o)[NDB], f32x16& negref, float& mrun, float& l, const bf16x8 (&qf)[NKS], const bf16_t* sK, int kst, VF valid, bool rowok = true) {
  const int lane = otid() & 63, r = lane & 31, h = lane >> 5;
  f32x16 s[2];
  constexpr int KG = 2;
#pragma unroll
  for (int k0 = 0; k0 < NKS; k0 += KG) {
    bf16x8 a[2][KG];
#pragma unroll
    for (int kb = 0; kb < 2; ++kb)
#pragma unroll
      for (int kk = 0; kk < KG; ++kk)
        if (k0 + kk < NKS) a[kb][kk] = *(const bf16x8*)(sK + (kb * 32 + r) * kst + (k0 + kk) * 16 + h * 8);
    __builtin_amdgcn_sched_group_barrier(0x100, 2 * KG, 0);
    __builtin_amdgcn_s_setprio(1);
#pragma unroll
    for (int kk = 0; kk < KG; ++kk)
#pragma unroll
      for (int kb = 0; kb < 2; ++kb)
        if (k0 + kk < NKS) {
          if (k0 + kk == 0) {
            if (REFC) s[kb] = mfma32(a[kb][kk], qf[0], negref);
            else { f32x16 z; _Pragma("unroll") for (int i_ = 0; i_ < 16; ++i_) z[i_] = 0.f; s[kb] = mfma32(a[kb][kk], qf[0], z); }
          } else s[kb] = mfma32(a[kb][kk], qf[k0 + kk], s[kb]);
        }
    __builtin_amdgcn_s_setprio(0);
    __builtin_amdgcn_sched_group_barrier(0x008, 2 * KG, 0);
  }
  if (!REFC) {
#pragma unroll
    for (int kb = 0; kb < 2; ++kb)
#pragma unroll
      for (int i = 0; i < 16; ++i) s[kb][i] += negref[0];
  }
  float mx = NEG_INF;
#pragma unroll
  for (int kb = 0; kb < 2; ++kb)
#pragma unroll
    for (int i = 0; i < 16; ++i) {
      if (MASKED == 1) { const float sv = valid(kb, i) ? s[kb][i] : NEG_INF; s[kb][i] = sv; }
      mx = fmaxf(mx, s[kb][i]);
    }
  if (MASKED == 2) mx = rowok ? mx : NEG_INF;
  mx = fmaxf(mx, __shfl_xor(mx, 32));
  float mr = fmaxf(mrun, mx);
  const bool need = (mr > 8.0f) || (mr < -8.0f && mr != NEG_INF);
  if (__ballot(need) != 0ull) {
    const float delta = need ? mr : 0.f;
    const float alpha = ex2(-delta);
#pragma unroll
    for (int kb = 0; kb < 2; ++kb)
#pragma unroll
      for (int i = 0; i < 16; ++i) s[kb][i] -= delta;
#pragma unroll
    for (int db = 0; db < NDB; ++db)
#pragma unroll
      for (int i = 0; i < 16; ++i) o[db][i] *= alpha;
#pragma unroll
    for (int i = 0; i < 16; ++i) negref[i] -= delta;
    l *= alpha;
    mr -= delta;
  }
  mrun = mr;
  float ps = 0.f;
#pragma unroll
  for (int kb = 0; kb < 2; ++kb)
#pragma unroll
    for (int i = 0; i < 16; ++i) { const float pv = ex2(s[kb][i]); s[kb][i] = pv; ps += pv; }
  if (MASKED == 2) ps = rowok ? ps : 0.f;
  l += ps;
#pragma unroll
  for (int kb = 0; kb < 2; ++kb)
#pragma unroll
    for (int s2 = 0; s2 < 2; ++s2)
#pragma unroll
      for (int jj = 0; jj < 4; ++jj) {
        const unsigned w = pk2(s[kb][8 * s2 + 2 * jj], s[kb][8 * s2 + 2 * jj + 1]);
        pw[kb * 2 + s2][jj] = (MASKED == 2) ? (rowok ? w : 0u) : w;
      }
}
template <int NKS, int NDB, int MASKED, class VF>
DI void qk_softmax_s(u32x4 (&pw)[4], f32x16 (&o)[NDB], f32x16& negref, float& mrun, float& l, const bf16x8 (&qf)[NKS], const bf16_t* sK, int kst, VF valid) {
  qk_softmax<NKS, NDB, MASKED, VF, true>(pw, o, negref, mrun, l, qf, sK, kst, valid);
}
template <int NDB>
DI void pv_tile(f32x16 (&o)[NDB], const u32x4 (&pw)[4], const bf16_t* sVt, int vst) {
  const int lane = otid() & 63, r = lane & 31, h = lane >> 5;
#pragma unroll
  for (int kb = 0; kb < 2; ++kb)
#pragma unroll
    for (int s2 = 0; s2 < 2; ++s2) {
      const bf16x8 pf = __builtin_bit_cast(bf16x8, pw[kb * 2 + s2]);
      bf16x8 a[NDB];
#pragma unroll
      for (int db = 0; db < NDB; ++db) a[db] = *(const bf16x8*)(sVt + (db * 32 + r) * vst + kb * 32 + s2 * 16 + h * 8);
      __builtin_amdgcn_sched_group_barrier(0x100, NDB, 0);
      __builtin_amdgcn_s_setprio(1);
#pragma unroll
      for (int db = 0; db < NDB; ++db) o[db] = mfma32(a[db], pf, o[db]);
      __builtin_amdgcn_s_setprio(0);
      __builtin_amdgcn_sched_group_barrier(0x008, NDB, 0);
    }
}
DI bool wave_skew(int wid) { return (((wid & 1) ^ (wid >> 2)) & 1) != 0; }

#define FLASH_STATE(NDB) f32x16 o[NDB]; f32x16 negref; float mrun = NEG_INF, l = 0.f; \
  _Pragma("unroll") for (int i_ = 0; i_ < 16; ++i_) { negref[i_] = 0.f; _Pragma("unroll") for (int db_ = 0; db_ < NDB; ++db_) o[db_][i_] = 0.f; }

DI void idx_phase(char* smem, const Params& p) {
  const int tid = otid(), lane = tid & 63, wid = tid >> 6, fr = lane & 15, fq = lane >> 4;
  unsigned* hw = (unsigned*)smem + wid * 2048;
  float* scr = p.SCR + (long)obid() * 16 * 2048;
  for (int rnd = 0; rnd * (int)gridDim.x < NB * 128; ++rnd) {
    const int it = rnd * (int)gridDim.x + ((rnd & 1) ? ((int)gridDim.x - 1 - obid()) : obid());
    if (it >= NB * 128) break;
    const int qt = 127 - it / NB, b = it % NB, q0 = qt * 16;
    const bf16_t* yb = p.Y + (long)b * T * LDE;
    bf16x8 qf[8][2];
#pragma unroll
    for (int hh = 0; hh < 8; ++hh)
#pragma unroll
      for (int ks = 0; ks < 2; ++ks) qf[hh][ks] = *(const bf16x8*)(yb + (long)(q0 + fr) * LDE + E_IQ + hh * 64 + ks * 32 + fq * 8);
    float w[8];
    {
      const f32x4 w0 = *(const f32x4*)(p.IW + ((long)b * T + q0 + fr) * 8), w1 = *(const f32x4*)(p.IW + ((long)b * T + q0 + fr) * 8 + 4);
      w[0] = w0[0]; w[1] = w0[1]; w[2] = w0[2]; w[3] = w0[3]; w[4] = w1[0]; w[5] = w1[1]; w[6] = w1[2]; w[7] = w1[3];
    }
    __syncthreads();
    {
      const bf16_t* kbase = yb + (long)fr * LDE + E_IK + fq * 8;
      bf16x8 kf[2], nf[2];
      int kt = wid;
      if (kt <= qt) { kf[0] = *(const bf16x8*)(kbase + (long)(kt * 16) * LDE); kf[1] = *(const bf16x8*)(kbase + (long)(kt * 16) * LDE + 32); }
      for (; kt <= qt; kt += 8) {
        if (kt + 8 <= qt) { nf[0] = *(const bf16x8*)(kbase + (long)((kt + 8) * 16) * LDE); nf[1] = *(const bf16x8*)(kbase + (long)((kt + 8) * 16) * LDE + 32); }
        f32x4 sc = {0.f, 0.f, 0.f, 0.f};
#pragma unroll
        for (int hh = 0; hh < 8; ++hh) {
          f32x4 a = {0.f, 0.f, 0.f, 0.f};
          a = mfma16(kf[0], qf[hh][0], a);
          a = mfma16(kf[1], qf[hh][1], a);
#pragma unroll
          for (int j = 0; j < 4; ++j) sc[j] += fmaxf(a[j], 0.f) * w[hh];
        }
        *(f32x4*)(scr + fr * 2048 + kt * 16 + fq * 4) = sc;
        kf[0] = nf[0]; kf[1] = nf[1];
      }
    }
    __syncthreads();
#pragma unroll 1
    for (int qq = 0; qq < 2; ++qq) {
      const int ql = wid * 2 + qq, t = q0 + ql;
      u64* outw = p.SEL + ((long)b * T + t) * 32;
      if (t < 256) {
        if (lane < 32) { const int lo = lane * 64; outw[lane] = (t >= lo + 63) ? ~0ull : (t < lo ? 0ull : ((1ull << (t - lo + 1)) - 1ull)); }
        continue;
      }
      const int ne = (t >> 6) + 1;
      unsigned key[32];
      float sv[32];
#pragma unroll
      for (int e = 0; e < 32; ++e) sv[e] = scr[ql * 2048 + e * 64 + lane];
#pragma unroll
      for (int e = 0; e < 32; ++e) {
        const int s = e * 64 + lane;
        const float v = sv[e] + 0.0f;
        unsigned u = __float_as_uint(v);
        u = (u & 0x80000000u) ? ~u : (u | 0x80000000u);
        key[e] = (s <= t) ? u : 0u;
      }
      unsigned prefix = 0; unsigned kk = 256; int sh = 32; bool whole = false;
#pragma unroll 1
      for (int pass = 0; pass < 4; ++pass) {
        const int shift = 24 - 8 * pass;
#pragma unroll
        for (int k = 0; k < 8; ++k) *(u32x4*)(hw + lane * 4 + k * 256) = (u32x4){0u, 0u, 0u, 0u};
#pragma unroll
        for (int e = 0; e < 32; ++e) {
          if (e < ne) {
            const unsigned u = key[e];
            const bool match = (pass == 0) || ((u >> (shift + 8)) == prefix);
            if (match) atomicAdd(hw + ((u >> shift) & 255u) * 8 + (lane & 7), 1u);
          }
        }
        u32x4 c;
#pragma unroll
        for (int bb = 0; bb < 4; ++bb) {
          const u32x4 s0 = *(const u32x4*)(hw + lane * 32 + bb * 8), s1 = *(const u32x4*)(hw + lane * 32 + bb * 8 + 4);
          c[bb] = ((s0[0] + s0[1]) + (s0[2] + s0[3])) + ((s1[0] + s1[1]) + (s1[2] + s1[3]));
        }
        const unsigned S = c[0] + c[1] + c[2] + c[3];
        unsigned Tl = S;
#pragma unroll
        for (int off = 1; off < 64; off <<= 1) { const unsigned v = __shfl_down(Tl, off); if (lane + off < 64) Tl += v; }
        unsigned a = Tl - S; int found = -1; unsigned nk = 0, cb = 0;
        if (a < kk && a + c[3] >= kk) { found = 3; nk = kk - a; cb = c[3]; } a += c[3];
        if (found < 0 && a < kk && a + c[2] >= kk) { found = 2; nk = kk - a; cb = c[2]; } a += c[2];
        if (found < 0 && a < kk && a + c[1] >= kk) { found = 1; nk = kk - a; cb = c[1]; } a += c[1];
        if (found < 0 && a < kk && a + c[0] >= kk) { found = 0; nk = kk - a; cb = c[0]; }
        const u64 bal = __ballot(found >= 0);
        const int src = __ffsll((long long)bal) - 1;
        const unsigned digit = (unsigned)__shfl(lane * 4 + found, src);
        kk = (unsigned)__shfl((int)nk, src);
        const unsigned cbin = (unsigned)__shfl((int)cb, src);
        prefix = (prefix << 8) | digit;
        sh = shift;
        if (cbin == kk) { whole = true; break; }
      }
      unsigned run = 0; u64 myword = 0;
      if (whole) {
#pragma unroll
        for (int e = 0; e < 32; ++e) {
          if (e < ne) {
            const u64 wsel = __ballot((key[e] >> sh) >= prefix);
            if (lane == e) myword = wsel;
          }
        }
      } else
#pragma unroll
      for (int e = 0; e < 32; ++e) {
        if (e < ne) {
          const unsigned u = key[e] >> sh;
          const bool eq = (u == prefix);
          const u64 be = __ballot(eq);
          const unsigned rank = run + (unsigned)__popcll(be & ((1ull << lane) - 1ull));
          const bool selb = (u > prefix) || (eq && rank < kk);
          const u64 wsel = __ballot(selb);
          run += (unsigned)__popcll(be);
          if (lane == e) myword = wsel;
        }
      }
      if (lane < 32) outw[lane] = myword;
    }
  }
}

constexpr int DSA_BUF = 39936;
DI void dsa_phase(char* smem, const Params& p, int j) {
  bf16_t* sK = (bf16_t*)smem;
  bf16_t* sVt = sK + 64 * 168;
  const int tid = otid(), lane = tid & 63, wid = tid >> 6, r = lane & 31, h = lane >> 5;
  const bool ldv = tid < 256, skew = wave_skew(wid);
  for (int rnd = 0; rnd * (int)gridDim.x < NB * 64; ++rnd) {
    const int it = rnd * (int)gridDim.x + ((rnd & 1) ? ((int)gridDim.x - 1 - obid()) : obid());
    if (it >= NB * 64) break;
    const int qt = 63 - it / NB, b = it % NB;
    const int tl = otid();
    const int g4 = tl & 15, dg = (tl >> 4) & 15, rk = (tl & 255) >> 2, rc = tl & 3;
    const int head = wid, q0 = qt * 32, tq = q0 + r;
    const bf16_t* yb = p.Y + (long)b * T * LDE;
    bf16x8 qf[10];
    {
      bf16x8 qn[4];
#pragma unroll
      for (int ks = 0; ks < 4; ++ks) qn[ks] = *(const bf16x8*)(yb + (long)tq * LDE + E_QNOPE + head * 64 + ks * 16 + h * 8);
      const bf16_t* wuk = p.WUKT + ((long)(j * 8 + head) * 128 + r) * 64 + h * 8;
#pragma unroll
      for (int cb = 0; cb < 4; ++cb) {
        int cbo = cb * 32 * 64;
        asm volatile("" : "+v"(cbo));
        const bf16_t* wk = wuk + cbo;
        f32x16 ql;
#pragma unroll
        for (int i = 0; i < 16; ++i) ql[i] = 0.f;
#pragma unroll
        for (int ks = 0; ks < 4; ++ks) { const bf16x8 a = *(const bf16x8*)(wk + ks * 16); ql = mfma32(a, qn[ks], ql); }
#pragma unroll
        for (int s2 = 0; s2 < 2; ++s2) {
          u32x4 w;
#pragma unroll
          for (int jj = 0; jj < 4; ++jj) w[jj] = pk2(ql[8 * s2 + 2 * jj] * QS_A, ql[8 * s2 + 2 * jj + 1] * QS_A);
          qf[cb * 2 + s2] = __builtin_bit_cast(bf16x8, w);
        }
        __builtin_amdgcn_sched_barrier(0);
      }
    }
    __builtin_amdgcn_sched_barrier(0);
    int tq2 = tq; asm volatile("" : "+v"(tq2));
#pragma unroll
    for (int ks = 0; ks < 2; ++ks) qf[8 + ks] = *(const bf16x8*)(yb + (long)tq2 * LDE + E_QROPE + head * 32 + ks * 16 + h * 8);
    const u64* selrow = p.SEL + ((long)b * T + tq2) * 32;
    FLASH_STATE(4)
    const int nkt = ((q0 + 31) >> 6) + 1;
    u32x4 kv[4];
    auto issue = [&](int kt) {
      const bf16_t* base = yb + (long)(kt * 64) * LDE + E_CKV;
      if (ldv) {
#pragma unroll
        for (int i = 0; i < 4; ++i) kv[i] = *(const u32x4*)(base + (long)(g4 * 4 + i) * LDE + dg * 8);
      } else kv[0] = *(const u32x4*)(base + (long)rk * LDE + 128 + rc * 8);
    };
    auto stash = [&](int buf) {
      bf16_t* bK = sK + buf * (DSA_BUF / 2); bf16_t* bV = sVt + buf * (DSA_BUF / 2);
      if (ldv) {
#pragma unroll
        for (int i = 0; i < 4; ++i) {
          bf16_t* rowp = bK + (g4 * 4 + i) * 168 + (dg >> 1) * 16 + (dg & 1) * 4;
          *(u32x2*)rowp = (u32x2){kv[i][0], kv[i][1]};
          *(u32x2*)(rowp + 8) = (u32x2){kv[i][2], kv[i][3]};
        }
        vt_write(bV, 72, dg * 8, vt_pos(g4), kv);
      } else *(u32x4*)(bK + rk * 168 + 128 + rc * 8) = kv[0];
    };
    issue(0);
    __syncthreads();
    stash(0);
    if (nkt > 1) issue(1);
    __syncthreads();
    u32x4 pw[4];
    u64 word = selrow[0];
    for (int kt = 0; kt < nkt; ++kt) {
      const int buf = kt % 3;
      const u64 wnext = selrow[kt + 1 < nkt ? kt + 1 : kt];
      const unsigned wlo = (unsigned)word >> (4 * h), whi = (unsigned)(word >> 32) >> (4 * h);
      if (skew) {
        if (kt > 0) pv_tile<4>(o, pw, sVt + ((kt - 1) % 3) * (DSA_BUF / 2), 72);
        qk_softmax_s<10, 4, 1>(pw, o, negref, mrun, l, qf, sK + buf * (DSA_BUF / 2), 168, [&](int kb, int i) { return (((kb ? whi : wlo) >> ((i & 3) + 8 * (i >> 2))) & 1u) != 0u; });
      } else {
        qk_softmax_s<10, 4, 1>(pw, o, negref, mrun, l, qf, sK + buf * (DSA_BUF / 2), 168, [&](int kb, int i) { return (((kb ? whi : wlo) >> ((i & 3) + 8 * (i >> 2))) & 1u) != 0u; });
        pv_tile<4>(o, pw, sVt + buf * (DSA_BUF / 2), 72);
      }
      word = wnext;
      if (kt + 1 < nkt) {
        stash((kt + 1) % 3);
        if (kt + 2 < nkt) issue(kt + 2);
        __syncthreads();
      }
    }
    if (skew) pv_tile<4>(o, pw, sVt + ((nkt - 1) % 3) * (DSA_BUF / 2), 72);
    l += __shfl_xor(l, 32);
    const float inv = l > 0.f ? 1.0f / l : 0.f;
    u32x4 pwv[8];
#pragma unroll
    for (int db = 0; db < 4; ++db)
#pragma unroll
      for (int s2 = 0; s2 < 2; ++s2)
#pragma unroll
        for (int jj = 0; jj < 4; ++jj) pwv[db * 2 + s2][jj] = pk2(o[db][8 * s2 + 2 * jj] * inv, o[db][8 * s2 + 2 * jj + 1] * inv);
    asm volatile("" ::: "memory");
    int r2 = r, h2 = h, head2 = head, b2 = b; asm volatile("" : "+v"(r2), "+v"(h2), "+v"(head2), "+s"(b2));
    const bf16_t* wuv = p.WUVP + ((long)(j * 8 + head2) * 64 + r2) * 128 + h2 * 8;
    f32x16 oo[2];
#pragma unroll
    for (int dblk = 0; dblk < 2; ++dblk) {
#pragma unroll
      for (int i = 0; i < 16; ++i) oo[dblk][i] = 0.f;
#pragma unroll
      for (int ks = 0; ks < 8; ++ks) {
        const bf16x8 a = *(const bf16x8*)(wuv + (long)dblk * 32 * 128 + ks * 16);
        oo[dblk] = mfma32(a, __builtin_bit_cast(bf16x8, pwv[ks]), oo[dblk]);
      }
    }
    bf16_t* orow = p.O + ((long)b2 * T + q0 + r2) * DM + head2 * 64;
#pragma unroll
    for (int dblk = 0; dblk < 2; ++dblk)
#pragma unroll
      for (int g = 0; g < 4; ++g)
        store_bf4(orow + dblk * 32 + 8 * g + 4 * h2, (f32x4){oo[dblk][4 * g], oo[dblk][4 * g + 1], oo[dblk][4 * g + 2], oo[dblk][4 * g + 3]});
  }
}

constexpr int DIFF_BUF = 35840;
DI void diff_phase(char* smem, const Params& p, int j, float lam_init) {
  bf16_t* sK = (bf16_t*)smem;
  bf16_t* sVt = sK + 64 * 136;
  float* cbuf = (float*)smem;
  const int tid = otid(), lane = tid & 63, wid = tid >> 6, r = lane & 31, h = lane >> 5, mp = wid >> 2, qs = wid & 3;
  const int g4 = tid & 15, dg = (tid >> 4) & 15, t2 = tid & 255;
  const bool ldv = tid < 256, skew = wave_skew(wid);
  float lam;
  {
    const float* lf = p.ev_lambda + j * 256;
    float d01 = lf[lane] * lf[64 + lane], d23 = lf[128 + lane] * lf[192 + lane];
#pragma unroll
    for (int off = 32; off >= 1; off >>= 1) { d01 += __shfl_xor(d01, off); d23 += __shfl_xor(d23, off); }
    lam = expf(d01) - expf(d23) + lam_init;
  }
  const float* subln = p.ev_subln + j * 128;
  for (int rnd = 0; rnd * (int)gridDim.x < NB * 4 * 16; ++rnd) {
    const int it = rnd * (int)gridDim.x + ((rnd & 1) ? ((int)gridDim.x - 1 - obid()) : obid());
    if (it >= NB * 4 * 16) break;
    const int qt = 15 - it / (NB * 4), rem = it % (NB * 4), b = rem >> 2, hd = rem & 3;
    const int q0 = qt * 128 + qs * 32, tq = q0 + r;
    const bf16_t* yb = p.Y + (long)b * T * LDE;
    bf16x8 qf[4];
#pragma unroll
    for (int ks = 0; ks < 4; ++ks) qf[ks] = *(const bf16x8*)(yb + (long)tq * LDE + E_QB + hd * 128 + mp * 64 + ks * 16 + h * 8);
    FLASH_STATE(4)
    const int nkt = 2 * qt + 2;
    u32x4 st[4];
    auto issue = [&](int kt) {
      const bf16_t* base = yb + (long)(kt * 64) * LDE;
      if (ldv) {
#pragma unroll
        for (int i = 0; i < 4; ++i) st[i] = *(const u32x4*)(base + (long)(g4 * 4 + i) * LDE + E_VB + hd * 128 + dg * 8);
      } else {
#pragma unroll
        for (int i = 0; i < 4; ++i) { const int c = t2 + i * 256; st[i] = *(const u32x4*)(base + (long)(c >> 4) * LDE + E_KB + hd * 128 + (c & 15) * 8); }
      }
    };
    auto stash = [&](int buf) {
      bf16_t* bK = sK + buf * (DIFF_BUF / 2); bf16_t* bV = sVt + buf * (DIFF_BUF / 2);
      if (ldv) vt_write(bV, 72, dg * 8, vt_pos(g4), st);
      else {
#pragma unroll
        for (int i = 0; i < 4; ++i) { const int c = t2 + i * 256; *(u32x4*)(bK + (c >> 4) * 136 + (c & 15) * 8) = st[i]; }
      }
    };
    issue(0);
    __syncthreads();
    stash(0);
    issue(1);
    __syncthreads();
    u32x4 pw[4]; bool havep = false; int pbuf = 0;
    for (int kt = 0; kt < nkt; ++kt) {
      const int buf = kt % 3;
      const bf16_t* bK = sK + buf * (DIFF_BUF / 2) + mp * 64; const bf16_t* bV = sVt + buf * (DIFF_BUF / 2);
      if (skew && havep) { pv_tile<4>(o, pw, sVt + pbuf * (DIFF_BUF / 2), 72); havep = false; }
      if (kt * 64 + 63 <= q0) {
        qk_softmax<4, 4, 0>(pw, o, negref, mrun, l, qf, bK, 136, [&](int kb, int i) { return true; });
        if (skew) { havep = true; pbuf = buf; } else pv_tile<4>(o, pw, bV, 72);
      } else if (kt * 64 <= q0 + 31) {
        const int lim = tq - kt * 64 - 4 * h;
        qk_softmax<4, 4, 1>(pw, o, negref, mrun, l, qf, bK, 136, [&](int kb, int i) { return kb * 32 + (i & 3) + 8 * (i >> 2) <= lim; });
        if (skew) { havep = true; pbuf = buf; } else pv_tile<4>(o, pw, bV, 72);
      }
      if (kt + 1 < nkt) {
        stash((kt + 1) % 3);
        if (kt + 2 < nkt) issue(kt + 2);
        __syncthreads();
      }
    }
    if (skew && havep) pv_tile<4>(o, pw, sVt + pbuf * (DIFF_BUF / 2), 72);
    l += __shfl_xor(l, 32);
    const float inv = l > 0.f ? 1.0f / l : 0.f;
    __syncthreads();
    if (mp == 1) {
#pragma unroll
      for (int db = 0; db < 4; ++db)
#pragma unroll
        for (int g = 0; g < 4; ++g)
          *(f32x4*)(cbuf + (qs * 32 + r) * 132 + db * 32 + 8 * g + 4 * h) = (f32x4){o[db][4 * g] * inv, o[db][4 * g + 1] * inv, o[db][4 * g + 2] * inv, o[db][4 * g + 3] * inv};
    }
    __syncthreads();
    if (mp == 0) {
      float ss = 0.f;
#pragma unroll
      for (int db = 0; db < 4; ++db)
#pragma unroll
        for (int g = 0; g < 4; ++g) {
          const f32x4 o1 = *(const f32x4*)(cbuf + (qs * 32 + r) * 132 + db * 32 + 8 * g + 4 * h);
#pragma unroll
          for (int jj = 0; jj < 4; ++jj) { const float a = o[db][4 * g + jj] * inv - lam * o1[jj]; o[db][4 * g + jj] = a; ss += a * a; }
        }
      ss += __shfl_xor(ss, 32);
      const float rs = (1.0f - lam_init) / sqrtf(ss * (1.0f / 128.0f) + 1e-6f);
      bf16_t* orow = p.O + ((long)b * T + tq) * DM + 512 + hd * 128;
#pragma unroll
      for (int db = 0; db < 4; ++db)
#pragma unroll
        for (int g = 0; g < 4; ++g) {
          const f32x4 sg = *(const f32x4*)(subln + db * 32 + 8 * g + 4 * h);
          store_bf4(orow + db * 32 + 8 * g + 4 * h, (f32x4){o[db][4 * g] * rs * sg[0], o[db][4 * g + 1] * rs * sg[1], o[db][4 * g + 2] * rs * sg[2], o[db][4 * g + 3] * rs * sg[3]});
        }
    }
  }
}

template <int MODE>
DI void nsa_branch(f32x16 (&tot)[2], float gate, unsigned tiles, const bf16x8 (&qf)[4], bf16_t* sK, bf16_t* sVt, const bf16_t* yb, int koff, int voff, int q0, int tq, unsigned mysel) {
  const int tid = otid(), lane = tid & 63, h = lane >> 5;
  const int g4 = tid & 15, dg = (tid >> 4) & 7, t2 = tid & 255;
  const bool ldv = tid < 128, ldk = tid >= 256;
  FLASH_STATE(2)
  unsigned rem = tiles;
  if (rem == 0u) return;
  u32x4 stA[2], stB[2];
  const int g2 = tid & 31, dg2 = (tid >> 5) & 7;
  const int vpos = vt_pos(g2 >> 1) + (g2 & 1) * 2;
  auto pop = [&]() { int r = -1; if (rem) { r = __ffs((int)rem) - 1; rem &= rem - 1u; } return r; };
  auto issue = [&](int jj, u32x4 (&st)[2]) {
    const bf16_t* base = yb + (long)(jj * 64) * LDO;
    if (tid < 256) {
#pragma unroll
      for (int i = 0; i < 2; ++i) st[i] = *(const u32x4*)(base + (long)(g2 * 2 + i) * LDO + voff + dg2 * 8);
    } else {
#pragma unroll
      for (int i = 0; i < 2; ++i) { const int c = t2 + i * 256; st[i] = *(const u32x4*)(base + (long)(c >> 3) * LDO + koff + (c & 7) * 8); }
    }
  };
  auto stash = [&](int buf, const u32x4 (&st)[2]) {
    if (tid < 256) vt_write2(sVt + buf * 4608, 72, dg2 * 8, vpos, st);
    else {
#pragma unroll
      for (int i = 0; i < 2; ++i) { const int c = t2 + i * 256; *(u32x4*)(sK + buf * 4608 + (c >> 3) * 72 + (c & 7) * 8) = st[i]; }
    }
  };
  u32x4 pw[4]; bool havep = false; int pbuf = 0;
  const bool skew = wave_skew(tid >> 6);
  int buf = 0;
  int j0 = pop(), j1 = pop(), j2 = pop();
  auto tile_step = [&](u32x4 (&st)[2]) {
    const int j = j0;
    const bf16_t* bK = sK + buf * 4608; const bf16_t* bV = sVt + buf * 4608;
    const int lim = tq - j * 64 - 4 * h;
    if (skew && havep) { pv_tile<2>(o, pw, sVt + pbuf * 4608, 72); havep = false; }
    bool done = false;
    if (MODE == 0) {
      const bool selb = ((mysel >> j) & 1u) != 0u;
      const unsigned long long bal = __ballot(selb);
      if (j * 64 <= q0 + 31 && bal != 0ull) {
        if (j * 64 + 63 <= q0 && bal == ~0ull)
          qk_softmax<4, 2, 0>(pw, o, negref, mrun, l, qf, bK, 72, [&](int kb, int i) { return true; });
        else if (j * 64 + 63 <= q0)
          qk_softmax<4, 2, 2>(pw, o, negref, mrun, l, qf, bK, 72, [&](int kb, int i) { return true; }, selb);
        else
          qk_softmax<4, 2, 1>(pw, o, negref, mrun, l, qf, bK, 72, [&](int kb, int i) { return selb && (kb * 32 + (i & 3) + 8 * (i >> 2) <= lim); });
        done = true;
      }
    } else {
      if (j * 64 <= q0 + 31 && j * 64 + 63 > q0 - 512) {
        if (j * 64 + 63 <= q0 && j * 64 > q0 + 31 - 512)
          qk_softmax<4, 2, 0>(pw, o, negref, mrun, l, qf, bK, 72, [&](int kb, int i) { return true; });
        else
          qk_softmax<4, 2, 1>(pw, o, negref, mrun, l, qf, bK, 72, [&](int kb, int i) { const int kk = kb * 32 + (i & 3) + 8 * (i >> 2); return kk <= lim && kk > lim - 512; });
        done = true;
      }
    }
    if (done) { if (skew) { havep = true; pbuf = buf; } else pv_tile<2>(o, pw, bV, 72); }
    if (j1 >= 0) {
      const int nbuf = buf == 2 ? 0 : buf + 1;
      stash(nbuf, st);
      const int j3 = pop();
      if (j3 >= 0) issue(j3, st);
      __syncthreads();
      buf = nbuf;
      j0 = j1; j1 = j2; j2 = j3;
    } else j0 = -1;
  };
  issue(j0, stA);
  __syncthreads();
  stash(0, stA);
  if (j1 >= 0) issue(j1, stB);
  if (j2 >= 0) issue(j2, stA);
  __syncthreads();
  while (j0 >= 0) {
    tile_step(stB);
    if (j0 >= 0) tile_step(stA);
  }
  if (skew && havep) pv_tile<2>(o, pw, sVt + pbuf * 4608, 72);
  l += __shfl_xor(l, 32);
  const float inv = l > 0.f ? gate / l : 0.f;
#pragma unroll
  for (int db = 0; db < 2; ++db)
#pragma unroll
    for (int i = 0; i < 16; ++i) tot[db][i] += o[db][i] * inv;
}

DI void nsa_phase(char* smem, const Params& p) {
  bf16_t* sK = (bf16_t*)smem;
  bf16_t* sVt = (bf16_t*)(smem + 18432);
  float* impb = (float*)(smem + 35840);
  float* imps = (float*)(smem + 69632);
  unsigned* selm = (unsigned*)(smem + 78080);
  const int tid = otid(), lane = tid & 63, wid = tid >> 6, r = lane & 31, h = lane >> 5, hh = wid & 3, qs = wid >> 2;
  for (int rnd = 0; rnd * (int)gridDim.x < NB * 32 * 4; ++rnd) {
    const int it = rnd * (int)gridDim.x + ((rnd & 1) ? ((int)gridDim.x - 1 - obid()) : obid());
    if (it >= NB * 32 * 4) break;
    const int qt = 31 - it / (NB * 4), rem = it % (NB * 4), b = rem >> 2, g = rem & 3;
    const int head = g * 4 + hh, q0 = qt * 64 + qs * 32, tq = q0 + r;
    const long tok = (long)b * T + tq;
    const bf16_t* yb = p.Y + (long)b * T * LDO;
    bf16x8 qf[4];
#pragma unroll
    for (int ks = 0; ks < 4; ++ks) qf[ks] = *(const bf16x8*)(yb + (long)tq * LDO + O_Q + head * 64 + ks * 16 + h * 8);
    const float g0 = p.GATES[tok * 48 + head * 3 + 0], g1 = p.GATES[tok * 48 + head * 3 + 1], g2 = p.GATES[tok * 48 + head * 3 + 2];
    __syncthreads();
    {
#pragma unroll
      for (int i = 0; i < 2; ++i) {
        const int c = tid + i * 512, row = c >> 3, cc = (c & 7) * 8;
        *(u32x4*)(sK + row * 72 + cc) = *(const u32x4*)(p.KCMP + ((long)(b * 128 + row) * 4 + g) * 64 + cc);
      }
      if (tid < 256) {
        const int g4 = tid & 31, dg = tid >> 5;
        u32x4 vv[4];
#pragma unroll
        for (int i = 0; i < 4; ++i) vv[i] = *(const u32x4*)(p.VCMP + ((long)(b * 128 + g4 * 4 + i) * 4 + g) * 64 + dg * 8);
        vt_write(sVt, 136, dg * 8, vt_pos(g4), vv);
      }
    }
    __syncthreads();
    f32x16 tot[2];
    {
      f32x16 s[4];
#pragma unroll
      for (int kb = 0; kb < 4; ++kb) {
#pragma unroll
        for (int i = 0; i < 16; ++i) s[kb][i] = 0.f;
#pragma unroll
        for (int ks = 0; ks < 4; ++ks) { const bf16x8 a = *(const bf16x8*)(sK + (kb * 32 + r) * 72 + ks * 16 + h * 8); s[kb] = mfma32(a, qf[ks], s[kb]); }
      }
      const int nlim = (tq >= 31 ? ((tq - 31) >> 4) : -1) - 4 * h;
      float mx = NEG_INF;
#pragma unroll
      for (int kb = 0; kb < 4; ++kb)
#pragma unroll
        for (int i = 0; i < 16; ++i) { const bool v = kb * 32 + (i & 3) + 8 * (i >> 2) <= nlim; const float sv = v ? s[kb][i] : NEG_INF; s[kb][i] = sv; mx = fmaxf(mx, sv); }
      mx = fmaxf(mx, __shfl_xor(mx, 32));
      const float muse = (mx == NEG_INF) ? 0.f : mx;
      float ps = 0.f;
#pragma unroll
      for (int kb = 0; kb < 4; ++kb)
#pragma unroll
        for (int i = 0; i < 16; ++i) { const float pv = ex2(s[kb][i] - muse); s[kb][i] = pv; ps += pv; }
      ps += __shfl_xor(ps, 32);
      const float inv = ps > 0.f ? 1.0f / ps : 0.f;
#pragma unroll
      for (int kb = 0; kb < 4; ++kb)
#pragma unroll
        for (int i = 0; i < 16; ++i) s[kb][i] *= inv;
      float part[4][4], recv[4][4];
#pragma unroll
      for (int kb = 0; kb < 4; ++kb)
#pragma unroll
        for (int g8 = 0; g8 < 4; ++g8) {
          part[kb][g8] = (s[kb][4 * g8] + s[kb][4 * g8 + 1]) + (s[kb][4 * g8 + 2] + s[kb][4 * g8 + 3]);
          recv[kb][g8] = __shfl_xor(s[kb][4 * g8 + 3], 32);
        }
#pragma unroll
      for (int kb = 0; kb < 4; ++kb)
#pragma unroll
        for (int g8 = 0; g8 < 4; ++g8) {
          float prev;
          if (h == 1) prev = recv[kb][g8];
          else prev = (g8 > 0) ? recv[kb][g8 - 1] : (kb > 0 ? recv[kb - 1][3] : 0.f);
          impb[(hh * 64 + qs * 32 + r) * 33 + kb * 8 + 2 * g8 + h] = part[kb][g8] + prev;
        }
      f32x16 oc[2];
#pragma unroll
      for (int db = 0; db < 2; ++db)
#pragma unroll
        for (int i = 0; i < 16; ++i) oc[db][i] = 0.f;
#pragma unroll
      for (int kb = 0; kb < 4; ++kb)
#pragma unroll
        for (int s2 = 0; s2 < 2; ++s2) {
          u32x4 pw;
#pragma unroll
          for (int jj = 0; jj < 4; ++jj) pw[jj] = pk2(s[kb][8 * s2 + 2 * jj], s[kb][8 * s2 + 2 * jj + 1]);
          const bf16x8 pf = __builtin_bit_cast(bf16x8, pw);
#pragma unroll
          for (int db = 0; db < 2; ++db) {
            const bf16x8 a = *(const bf16x8*)(sVt + (db * 32 + r) * 136 + kb * 32 + s2 * 16 + h * 8);
            oc[db] = mfma32(a, pf, oc[db]);
          }
        }
#pragma unroll
      for (int db = 0; db < 2; ++db)
#pragma unroll
        for (int i = 0; i < 16; ++i) tot[db][i] = oc[db][i] * g0;
    }
    __syncthreads();
    {
      const int rr = tid >> 3, t = qt * 64 + rr, cur = t >> 6;
#pragma unroll
      for (int jj = 0; jj < 4; ++jj) {
        const int j = (tid & 7) * 4 + jj;
        float v = (impb[(0 * 64 + rr) * 33 + j] + impb[(1 * 64 + rr) * 33 + j]) + (impb[(2 * 64 + rr) * 33 + j] + impb[(3 * 64 + rr) * 33 + j]);
        const bool forced = (j == 0) || (j == cur) || (j == cur - 1);
        const bool adm = j * 64 <= t;
        v = forced ? __builtin_huge_valf() : v;
        v = adm ? v : NEG_INF;
        imps[rr * 33 + j] = v;
      }
    }
    __syncthreads();
    {
      const int rr = tid >> 3;
      unsigned bits = 0;
#pragma unroll
      for (int jj = 0; jj < 4; ++jj) {
        const int j = (tid & 7) * 4 + jj;
        const float v = imps[rr * 33 + j];
        int cnt = 0;
#pragma unroll 8
        for (int j2 = 0; j2 < 32; ++j2) { const float v2 = imps[rr * 33 + j2]; cnt += ((v2 > v) || (v2 == v && j2 < j)) ? 1 : 0; }
        if (cnt < 16) bits |= 1u << j;
      }
      bits |= __shfl_xor((int)bits, 1); bits |= __shfl_xor((int)bits, 2); bits |= __shfl_xor((int)bits, 4);
      if ((tid & 7) == 0) selm[rr] = bits;
    }
    __syncthreads();
    const unsigned mysel = selm[qs * 32 + r];
    unsigned U = selm[r] | selm[32 + r];
#pragma unroll
    for (int off = 1; off < 32; off <<= 1) U |= (unsigned)__shfl_xor((int)U, off);
    const int jmax = qt;
    const unsigned causal = (jmax >= 31) ? 0xffffffffu : ((1u << (jmax + 1)) - 1u);
    U &= causal;
    U = (unsigned)__builtin_amdgcn_readfirstlane((int)U);
    nsa_branch<0>(tot, g1, U, qf, (bf16_t*)smem, (bf16_t*)(smem + 27648), yb, O_KS + g * 64, O_VS + g * 64, q0, tq, mysel);
    const int jlo = (qt * 64 >= 511 ? (qt * 64 - 511) : 0) >> 6;
    const unsigned W = causal & ~((1u << jlo) - 1u);
    nsa_branch<1>(tot, g2, W, qf, (bf16_t*)smem, (bf16_t*)(smem + 27648), yb, O_KW + g * 64, O_VW + g * 64, q0, tq, 0u);
    bf16_t* orow = p.O + tok * 1024 + head * 64;
#pragma unroll
    for (int db = 0; db < 2; ++db)
#pragma unroll
      for (int gg = 0; gg < 4; ++gg)
        store_bf4(orow + db * 32 + 8 * gg + 4 * h, (f32x4){tot[db][4 * gg], tot[db][4 * gg + 1], tot[db][4 * gg + 2], tot[db][4 * gg + 3]});
  }
}

#define XB_TMO      128
#define XB_XCNT(j)  (256  + 64 * (j))
#define XB_XSUB(j)  (1280 + 64 * (j))
#define XB_XGEN(j)  (2304 + 64 * (j))
#define XB_TOP      3328
#define XB_TOPGEN   3392
#define XCD_BAR_WORDS 3456
#define XB_SPIN_CAP (1u << 18)
#define XLAS __attribute__((address_space(3)))

__device__ __forceinline__ unsigned xb_ld(unsigned* p)              { return __hip_atomic_load(p, __ATOMIC_RELAXED, __HIP_MEMORY_SCOPE_AGENT); }
__device__ __forceinline__ unsigned xb_add(unsigned* p, unsigned v) { return __hip_atomic_fetch_add(p, v, __ATOMIC_RELAXED, __HIP_MEMORY_SCOPE_AGENT); }
__device__ __forceinline__ unsigned xb_xcc_id() { return (unsigned)__builtin_amdgcn_s_getreg((3 << 11) | 20) & 0xFu; }
#define XB_SPIN(cond, bar) do { unsigned _sp = 0; while (cond) { __builtin_amdgcn_s_sleep(1); \
    if ((++_sp & 255u) == 0u) { if (xb_ld(&(bar)[XB_TMO])) break; if (_sp > XB_SPIN_CAP) { atomicAdd(&(bar)[XB_TMO], 1u); break; } } } } while (0)

struct XcdBarrier {
    unsigned* bar; unsigned x;
    volatile XLAS unsigned* st;
};

__device__ __forceinline__ XcdBarrier xcd_barrier_post(unsigned* bar, volatile XLAS unsigned* st) {
    XcdBarrier b; b.bar = bar; b.x = xb_xcc_id(); b.st = st;
    if (threadIdx.x == 0) (void)xb_add(&bar[XB_XCNT(b.x)], 1u);
    return b;
}
__device__ __forceinline__ void xcd_barrier_complete(unsigned* bar, unsigned x, unsigned& nloc, unsigned& nx) {
    const unsigned G = gridDim.x * gridDim.y * gridDim.z;
    unsigned sum, cnt, mine, sp = 0u;
    for (;;) {
        sum = 0u; cnt = 0u; mine = 0u;
#pragma unroll
        for (unsigned j = 0; j < 16; ++j) { const unsigned c = xb_ld(&bar[XB_XCNT(j)]); sum += c; cnt += (c > 0u) ? 1u : 0u; mine = (j == x) ? c : mine; }
        if (sum == G) break;
        __builtin_amdgcn_s_sleep(1);
        if ((++sp & 255u) == 0u) { if (xb_ld(&bar[XB_TMO])) break; if (sp > XB_SPIN_CAP) { atomicAdd(&bar[XB_TMO], 1u); break; } }
    }
    nloc = mine > 0u ? mine : 1u; nx = cnt > 0u ? cnt : 1u;
}

__device__ __forceinline__ void xcd_barrier(const XcdBarrier& b) {
    asm volatile("s_waitcnt vmcnt(0)" ::: "memory");
    __syncthreads();
    if (threadIdx.x == 0) {
        unsigned* bar = b.bar;
        __builtin_amdgcn_s_waitcnt(0);
        unsigned nloc = b.st[0], nx = b.st[1];
        if (nloc == 0u) { xcd_barrier_complete(bar, b.x, nloc, nx); b.st[0] = nloc; b.st[1] = nx; }
        const unsigned old = xb_add(&bar[XB_XSUB(b.x)], 1u);
        const unsigned gen = old / nloc;
        if (old + 1u == (gen + 1u) * nloc) {
            __builtin_amdgcn_fence(__ATOMIC_RELEASE, "agent");
            asm volatile("s_waitcnt vmcnt(0)" ::: "memory");
            const unsigned og = xb_add(&bar[XB_TOP], 1u);
            const unsigned tg = og / nx;
            if (og + 1u == (tg + 1u) * nx) xb_add(&bar[XB_TOPGEN], 1u);
            else XB_SPIN(xb_ld(&bar[XB_TOPGEN]) == tg, bar);
            __builtin_amdgcn_fence(__ATOMIC_ACQUIRE, "agent");
            xb_add(&bar[XB_XGEN(b.x)], 1u);
            asm volatile("s_waitcnt vmcnt(0)" ::: "memory");
        } else {
            XB_SPIN(xb_ld(&bar[XB_XGEN(b.x)]) == gen, bar);
            __builtin_amdgcn_fence(__ATOMIC_ACQUIRE, "agent");
            asm volatile("s_waitcnt vmcnt(0)" ::: "memory");
        }
    }
    __syncthreads();
}


constexpr int LDS_BYTES = 131072 + 4096 + 16;
__global__ void __launch_bounds__(512, 2) fwd_kernel(Params p) {
  cg::grid_group grid = cg::this_grid();
  extern __shared__ __attribute__((aligned(16))) unsigned char lds[];
  char* smem = (char*)lds;
  float* red = (float*)(lds + 131072);
  volatile XLAS unsigned* xst = (volatile XLAS unsigned*)(lds + 131072 + 4096);
  if (threadIdx.x == 0) { xst[0] = 0u; xst[1] = 0u; }
  __syncthreads();
  const XcdBarrier xbar = xcd_barrier_post(p.BAR, xst);
  if (p.out == nullptr) grid.sync();
  for (int rep = 0; rep < REP_PRO; ++rep) { prologue(smem, p); rmsnorm_phase<true>(p, p.x, p.norm_mix, p.H, nullptr); xcd_barrier(xbar); }
  if (blockIdx.x < 4 && threadIdx.x < 128) { float s = 0.f; for (int i = 0; i < 64; ++i) s += p.CBP[(blockIdx.x * 64 + i) * 128 + threadIdx.x]; p.CB[blockIdx.x * 128 + threadIdx.x] = s; }
  for (int r4 = 0; r4 < 40; ++r4) xcd_barrier(xbar);
  const float* xcur = p.x;
  for (int layer = 0; layer < 4; ++layer) {
    const int j = layer >> 1;
    bool mixed = false;
    if ((layer & 1) == 0) {
#if EN_EVEN
      mixed = true;
      if (layer != 0) { rmsnorm_phase<true>(p, xcur, p.norm_mix + layer * DM, p.H, nullptr);
      xcd_barrier(xbar); }
      for (int rep = 0; rep < REP_GEMM; ++rep) { big_gemm(lds, p.H, p.WE + (long)j * LDE * DM, LDE, DM, EpiEven{p.Y, p.IW, p.ev_kv_gain + j * 128, p.cos64, p.sin64, p.cos32, p.sin32, red});
      xcd_barrier(xbar); }
      for (int rep = 0; rep < REP_ATT; ++rep) {
#if EN_DSA
      for (int r2 = 0; r2 < REP_IDX; ++r2) idx_phase(smem, p);
#endif
#if EN_DIFF
      for (int r2 = 0; r2 < REP_DIFF; ++r2) diff_phase(smem, p, j, layer == 0 ? 0.2f : 0.47071301834358416f);
#else
      for (long i = (long)blockIdx.x * NTHR + threadIdx.x; i < (long)NTOK * 512; i += (long)gridDim.x * NTHR) p.O[(i >> 9) * DM + 512 + (i & 511)] = 0;
#endif
      xcd_barrier(xbar);
#if EN_DSA
      dsa_phase(smem, p, j);
#else
      for (long i = (long)blockIdx.x * NTHR + threadIdx.x; i < (long)NTOK * 512; i += (long)gridDim.x * NTHR) p.O[(i >> 9) * DM + (i & 511)] = 0;
#endif
      xcd_barrier(xbar);
      }
      big_gemm(lds, p.O, p.WEO + (long)j * DM * DM, DM, DM, EpiResid{xcur, p.out});
      xcd_barrier(xbar);
#endif
    } else {
#if EN_ODD
      mixed = true;
      rmsnorm_phase<true>(p, xcur, p.norm_mix + layer * DM, p.H, nullptr);
      xcd_barrier(xbar);
      for (int rep = 0; rep < REP_GEMM; ++rep) { big_gemm(lds, p.H, p.WO + (long)j * NODD * DM, NODD, DM, EpiOdd{p.Y, p.GATES, p.cos64, p.sin64});
      xcd_barrier(xbar); }
      cmp_phase(smem, p, j);
      xcd_barrier(xbar);
      for (int rep = 0; rep < REP_ATT; ++rep) { nsa_phase(smem, p);
      xcd_barrier(xbar); }
      big_gemm(lds, p.O, p.WOO + (long)j * DM * DM, DM, DM, EpiResid{xcur, p.out});
      xcd_barrier(xbar);
#endif
    }
    if (!mixed && layer == 0) {
      for (long i = (long)blockIdx.x * NTHR + threadIdx.x; i < (long)NTOK * DM / 4; i += (long)gridDim.x * NTHR) ((f32x4*)p.out)[i] = ((const f32x4*)p.x)[i];
      xcd_barrier(xbar);
    }
    xcur = p.out;
#if EN_FFN
    rmsnorm_phase<true>(p, xcur, p.norm_ffn + layer * DM, p.H, nullptr);
    xcd_barrier(xbar);
    for (int rep = 0; rep < REP_GEMM; ++rep) { big_gemm(lds, p.H, p.WGU + (long)layer * 2 * DFF * DM, 2 * DFF, DM, EpiSwiglu{p.Y});
    xcd_barrier(xbar); }
    big_gemm(lds, p.Y, p.WD + (long)layer * DM * DFF, DM, DFF, EpiResid{p.out, p.out});
    xcd_barrier(xbar);
#endif
  }
  rmsnorm_phase<false>(p, p.out, p.norm_final, nullptr, p.out);
}

extern "C" void kernel_launch(void* const* d_in, const int* in_sizes, int n_in, void* d_out, int out_size, void* d_ws, size_t ws_size, hipStream_t stream) {
  static int grid_blocks = 0;
  if (!grid_blocks) {
    int dev = 0, cus = 0, per_cu = 0;
    (void)hipGetDevice(&dev);
    (void)hipDeviceGetAttribute(&cus, hipDeviceAttributeMultiprocessorCount, dev);
    if (hipFuncSetAttribute((const void*)fwd_kernel, hipFuncAttributeMaxDynamicSharedMemorySize, LDS_BYTES) != hipSuccess) fprintf(stderr, "hipFuncSetAttribute failed\n");
    (void)hipOccupancyMaxActiveBlocksPerMultiprocessor(&per_cu, fwd_kernel, NTHR, LDS_BYTES);
    if (per_cu < 1) fprintf(stderr, "occupancy query says %d blocks per CU\n", per_cu);
    (void)hipGetLastError();
    grid_blocks = cus;
    if (grid_blocks > 256) grid_blocks = 256;
  }
  Params p{};
  const float* const* in = (const float* const*)d_in;
  p.x = in[0]; p.norm_mix = in[1]; p.norm_ffn = in[2]; p.norm_final = in[3]; p.ev_w_in = in[4]; p.ev_kv_gain = in[5]; p.ev_w_uk = in[6]; p.ev_w_uv = in[7];
  p.ev_lambda = in[8]; p.ev_subln = in[9]; p.ev_w_out = in[10]; p.od_w_in = in[11]; p.od_cmp_pe = in[12]; p.od_cmp_w1 = in[13]; p.od_cmp_w2 = in[14];
  p.od_w_out = in[15]; p.ffn_w_gate = in[16]; p.ffn_w_up = in[17]; p.ffn_w_down = in[18];
  p.out = (float*)d_out;
  char* w = (char*)d_ws; size_t off = 0;
  auto take = [&](size_t bytes) { char* r = w + off; off += (bytes + 255) & ~(size_t)255; return r; };
  p.WE = (bf16_t*)take((size_t)2 * LDE * DM * 2);
  p.WEO = (bf16_t*)take((size_t)2 * DM * DM * 2);
  p.WUVP = (bf16_t*)take((size_t)2 * 8 * 64 * 128 * 2);
  p.WUKT = (bf16_t*)take((size_t)2 * 8 * 128 * 64 * 2);
  p.WO = (bf16_t*)take((size_t)2 * NODD * DM * 2);
  p.WOO = (bf16_t*)take((size_t)2 * DM * DM * 2);
  p.WGU = (bf16_t*)take((size_t)4 * 2 * DFF * DM * 2);
  p.WD = (bf16_t*)take((size_t)4 * DM * DFF * 2);
  p.WC1 = (bf16_t*)take((size_t)4 * 128 * 2048 * 2);
  p.WC2 = (bf16_t*)take((size_t)4 * 128 * 128 * 2);
  p.CBP = (float*)take((size_t)4 * 64 * 128 * 4);
  p.CB = (float*)take((size_t)4 * 128 * 4);
  p.cos64 = (float*)take((size_t)T * 32 * 4); p.sin64 = (float*)take((size_t)T * 32 * 4);
  p.cos32 = (float*)take((size_t)T * 16 * 4); p.sin32 = (float*)take((size_t)T * 16 * 4);
  p.H = (bf16_t*)take((size_t)NTOK * DM * 2);
  p.Y = (bf16_t*)take((size_t)(NTOK + 64) * LDE * 2);
  p.O = (bf16_t*)take((size_t)NTOK * DM * 2);
  p.SEL = (u64*)take((size_t)NTOK * 32 * 8);
  p.IW = (float*)take((size_t)NTOK * 8 * 4);
  p.GATES = (float*)take((size_t)NTOK * 48 * 4);
  p.BAR = (unsigned*)take((size_t)XCD_BAR_WORDS * 4);
  p.SCR = (float*)p.H;
  p.CH = p.H; p.KCMP = p.H + (size_t)2 * 8192 * 128; p.VCMP = p.KCMP + (size_t)8192 * 64;
  if (off > ws_size) fprintf(stderr, "workspace too small: need %zu have %zu\n", off, ws_size);
  if (hipMemsetAsync(p.BAR, 0, (size_t)XCD_BAR_WORDS * 4, stream) != hipSuccess) fprintf(stderr, "memset of barrier words failed\n");
  void* args[] = {&p};
  hipError_t e = hipLaunchCooperativeKernel((void*)fwd_kernel, dim3(grid_blocks), dim3(NTHR), args, LDS_BYTES, stream);
  if (e != hipSuccess) fprintf(stderr, "cooperative launch failed: %s (grid %d)\n", hipGetErrorString(e), grid_blocks);
}
```

```cpp
#include <hip/hip_runtime.h>
#include <hip/hip_cooperative_groups.h>
#include <stdint.h>
#include <stdio.h>
namespace cg = cooperative_groups;

#ifndef EN_EVEN
#define EN_EVEN 1
#endif
#ifndef EN_ODD
#define EN_ODD 1
#endif
#ifndef EN_DSA
#define EN_DSA 1
#endif
#ifndef EN_DIFF
#define EN_DIFF 1
#endif
#ifndef EN_FFN
#define EN_FFN 1
#endif
#ifndef REP_ATT
#define REP_ATT 1
#endif
#ifndef REP_GEMM
#define REP_GEMM 1
#endif
#ifndef REP_IDX
#define REP_IDX 1
#endif
#ifndef REP_DIFF
#define REP_DIFF 1
#endif
#ifndef REP_PRO
#define REP_PRO 1
#endif

#define DI __device__ __forceinline__
typedef unsigned short bf16_t;
typedef short bf16x8 __attribute__((ext_vector_type(8)));
typedef float f32x2 __attribute__((ext_vector_type(2)));
typedef float f32x4 __attribute__((ext_vector_type(4)));
typedef float f32x16 __attribute__((ext_vector_type(16)));
typedef __bf16 bf16x2_t __attribute__((ext_vector_type(2)));
typedef unsigned u32x2 __attribute__((ext_vector_type(2)));
typedef unsigned u32x4 __attribute__((ext_vector_type(4)));
typedef unsigned long long u64;

constexpr int NTOK = 32768, T = 2048, NB = 16, DM = 1024, DFF = 2816;
constexpr int LDE = 3072, LDO = 2688, NODD = 2816, NTHR = 512;
constexpr int E_QNOPE = 0, E_QROPE = 512, E_CKV = 768, E_KROPE = 896, E_IQ = 928, E_IK = 1440, E_QB = 1504, E_KB = 2016, E_VB = 2528, E_IW = 3040;
constexpr int O_Q = 0, O_KC = 1024, O_VC = 1280, O_KS = 1536, O_VS = 1792, O_KW = 2048, O_VW = 2304, O_G = 2560;
constexpr float LOG2E = 1.4426950408889634f;
constexpr float NEG_INF = -__builtin_huge_valf();

struct Params {
  const float *x, *norm_mix, *norm_ffn, *norm_final, *ev_w_in, *ev_kv_gain, *ev_w_uk, *ev_w_uv, *ev_lambda, *ev_subln, *ev_w_out,
      *od_w_in, *od_cmp_pe, *od_cmp_w1, *od_cmp_w2, *od_w_out, *ffn_w_gate, *ffn_w_up, *ffn_w_down;
  float* out;
  bf16_t *WE, *WEO, *WO, *WOO, *WGU, *WD, *WC1, *WC2, *WUVP, *WUKT;
  float *CBP, *CB, *cos64, *sin64, *cos32, *sin32;
  bf16_t *H, *Y, *O;
  u64* SEL;
  float *IW, *GATES;
  float* SCR;
  bf16_t *CH, *KCMP, *VCMP;
  unsigned* BAR;
};

DI int otid() { int t = threadIdx.x; asm volatile("" : "+v"(t)); return t; }
DI int obid() { int b = blockIdx.x; asm volatile("" : "+s"(b)); return b; }
DI unsigned pk2(float a, float b) { f32x2 v = {a, b}; bf16x2_t r = __builtin_convertvector(v, bf16x2_t); return __builtin_bit_cast(unsigned, r); }
DI float bf2f(bf16_t v) { return __uint_as_float(((unsigned)v) << 16); }
DI float ex2(float x) { return __builtin_amdgcn_exp2f(x); }
DI f32x4 mfma16(bf16x8 a, bf16x8 b, f32x4 c) { return __builtin_amdgcn_mfma_f32_16x16x32_bf16(a, b, c, 0, 0, 0); }
DI f32x16 mfma32(bf16x8 a, bf16x8 b, f32x16 c) { return __builtin_amdgcn_mfma_f32_32x32x16_bf16(a, b, c, 0, 0, 0); }

DI void tconv(float* tile, const float* src, int sld, int c0, int n, int K, bf16_t* dst, int dld, int r0, int mode, int& base) {
  const int tid = otid(), lane = tid & 63, ch = lane & 7, c4i = lane >> 3;
  const int GW = gridDim.x * (NTHR / 64);
  const int ncg = (n + 31) >> 5, items = ncg * (K >> 6), n4 = n >> 2;
  int start = obid() * (NTHR / 64) + (tid >> 6) - base; if (start < 0) start += GW;
  for (int it = start; it < items; it += GW) {
    const int cg = it % ncg, ks = it / ncg, c4 = cg * 8 + c4i;
    if (c4 < n4) {
      const int cc0 = c4 * 4;
      const float* sp = src + (long)(ks * 64 + ch * 8) * sld + c0 + cc0;
      f32x4 v[8];
#pragma unroll
      for (int kk = 0; kk < 8; ++kk) v[kk] = *(const f32x4*)(sp + (long)kk * sld);
#pragma unroll
      for (int q = 0; q < 4; ++q) {
        const int cc = cc0 + q; int row = cc;
        if (mode == 1) row = (cc >> 4) * 32 + (cc & 15);
        else if (mode == 2) row = (cc >> 4) * 32 + 16 + (cc & 15);
        else if (mode == 3) row = (cc & ~63) + ((cc & 31) >> 4) * 32 + ((cc >> 5) & 1) * 16 + (cc & 15);
        u32x4 w; w[0] = pk2(v[0][q], v[1][q]); w[1] = pk2(v[2][q], v[3][q]); w[2] = pk2(v[4][q], v[5][q]); w[3] = pk2(v[6][q], v[7][q]);
        *(u32x4*)(dst + (long)(r0 + row) * dld + ks * 64 + ch * 8) = w;
      }
    }
  }
  base = (base + items) % GW;
}

DI void prologue(char* smem, const Params& p) {
  float* tile = (float*)smem;
  const int tid = otid(), G = gridDim.x, bid = obid();
  int base = 0;
  for (int l = 0; l < 4; ++l) {
    tconv(tile, p.ffn_w_gate + (long)l * DM * DFF, DFF, 0, DFF, DM, p.WGU + (long)l * 2 * DFF * DM, DM, 0, 1, base);
    tconv(tile, p.ffn_w_up + (long)l * DM * DFF, DFF, 0, DFF, DM, p.WGU + (long)l * 2 * DFF * DM, DM, 0, 2, base);
    tconv(tile, p.ffn_w_down + (long)l * DFF * DM, DM, 0, DM, DFF, p.WD + (long)l * DM * DFF, DFF, 0, 0, base);
  }
  for (int j = 0; j < 2; ++j) {
    const float* src = p.ev_w_in + (long)j * DM * 3048;
    bf16_t* dst = p.WE + (long)j * LDE * DM;
    tconv(tile, src, 3048, 0, 928, DM, dst, DM, 0, 0, base);
    tconv(tile, src, 3048, 928, 576, DM, dst, DM, E_IQ, 3, base);
    tconv(tile, src, 3048, 1504, 8, DM, dst, DM, E_IW, 0, base);
    tconv(tile, src, 3048, 1512, 1024, DM, dst, DM, E_QB, 3, base);
    tconv(tile, src, 3048, 2536, 512, DM, dst, DM, E_VB, 0, base);
    tconv(tile, p.ev_w_out + (long)j * DM * DM, DM, 0, DM, DM, p.WEO + (long)j * DM * DM, DM, 0, 0, base);
    {
      const float* so = p.od_w_in + (long)j * DM * 2608; bf16_t* dd = p.WO + (long)j * NODD * DM;
      tconv(tile, so, 2608, 0, 1280, DM, dd, DM, 0, 3, base);
      tconv(tile, so, 2608, 1280, 256, DM, dd, DM, 1280, 0, base);
      tconv(tile, so, 2608, 1536, 256, DM, dd, DM, 1536, 3, base);
      tconv(tile, so, 2608, 1792, 256, DM, dd, DM, 1792, 0, base);
      tconv(tile, so, 2608, 2048, 256, DM, dd, DM, 2048, 3, base);
      tconv(tile, so, 2608, 2304, 304, DM, dd, DM, 2304, 0, base);
    }
    tconv(tile, p.od_w_out + (long)j * DM * DM, DM, 0, DM, DM, p.WOO + (long)j * DM * DM, DM, 0, 0, base);
    for (int kv = 0; kv < 2; ++kv) {
      tconv(tile, p.od_cmp_w1 + (long)(j * 2 + kv) * 2048 * 128, 128, 0, 128, 2048, p.WC1 + (long)(j * 2 + kv) * 128 * 2048, 2048, 0, 0, base);
      tconv(tile, p.od_cmp_w2 + (long)(j * 2 + kv) * 128 * 64, 64, 0, 64, 128, p.WC2 + (long)(j * 2 + kv) * 128 * 128, 128, 0, 0, base);
    }
  }
  for (int idx = bid * NTHR + tid; idx < 2 * 8 * 128 * 64; idx += G * NTHR) {
    const int d = idx & 63, c = (idx >> 6) & 127, jh = idx >> 13;
    p.WUKT[idx] = (bf16_t)(pk2(p.ev_w_uk[((long)jh * 64 + d) * 128 + c], 0.f) & 0xffff);
  }
  for (int idx = bid * NTHR + tid; idx < 2 * 8 * 64 * 128; idx += G * NTHR) {
    const int pp = idx & 127, d = (idx >> 7) & 63, jh = idx >> 13;
    const int s = pp >> 4, hh = (pp >> 3) & 1, jj = pp & 7, c = 16 * s + 8 * (jj >> 2) + 4 * hh + (jj & 3);
    p.WUVP[idx] = (bf16_t)(pk2(p.ev_w_uv[((long)jh * 128 + c) * 64 + d], 0.f) & 0xffff);
  }
  for (int idx = bid * NTHR + tid; idx < T * 48; idx += G * NTHR) {
    const int pos = idx / 48, e = idx % 48;
    if (e < 32) {
      const float inv = (float)pow(10000.0, -(double)(2 * e) / 64.0);
      const float ang = (float)pos * inv;
      p.cos64[pos * 32 + e] = (float)cos((double)ang); p.sin64[pos * 32 + e] = (float)sin((double)ang);
    } else {
      const int i = e - 32;
      const float inv = (float)pow(10000.0, -(double)(2 * i) / 32.0);
      const float ang = (float)pos * inv;
      p.cos32[pos * 16 + i] = (float)cos((double)ang); p.sin32[pos * 16 + i] = (float)sin((double)ang);
    }
  }
  for (int it = bid; it < 4 * 16; it += G) {
    const int jk = it >> 4, ch = it & 15, c = tid & 127, q = tid >> 7;
    const float* pe = p.od_cmp_pe + (long)jk * 2048 + ch * 128 + q * 32;
    const float* w1 = p.od_cmp_w1 + ((long)jk * 2048 + ch * 128 + q * 32) * 128 + c;
    float s = 0.f;
#pragma unroll 8
    for (int f = 0; f < 32; ++f) s += pe[f] * w1[(long)f * 128];
    p.CBP[(jk * 64 + ch * 4 + q) * 128 + c] = s;
  }
}

template <bool TO_BF16>
DI void rmsnorm_phase(const Params& p, const float* xin, const float* gain, bf16_t* hout, float* fout) {
  const int lane = otid() & 63, wid = otid() >> 6;
  const int gw = obid() * 8 + wid, nw = gridDim.x * 8;
  f32x4 g[4];
#pragma unroll
  for (int i = 0; i < 4; ++i) g[i] = *(const f32x4*)(gain + i * 256 + lane * 4);
  for (int row = gw; row < NTOK; row += nw) {
    const float* xr = xin + (long)row * DM;
    f32x4 v[4]; float ss = 0.f;
#pragma unroll
    for (int i = 0; i < 4; ++i) { v[i] = __builtin_nontemporal_load((const f32x4*)(xr + i * 256 + lane * 4)); ss += v[i][0] * v[i][0] + v[i][1] * v[i][1] + v[i][2] * v[i][2] + v[i][3] * v[i][3]; }
#pragma unroll
    for (int off = 32; off >= 1; off >>= 1) ss += __shfl_xor(ss, off);
    const float rs = 1.0f / sqrtf(ss * (1.0f / DM) + 1e-6f);
#pragma unroll
    for (int i = 0; i < 4; ++i) {
      const f32x4 o = v[i] * rs * g[i];
      if (TO_BF16) { u32x2 w; w.x = pk2(o[0], o[1]); w.y = pk2(o[2], o[3]); *(u32x2*)(hout + (long)row * DM + i * 256 + lane * 4) = w; }
      else *(f32x4*)(fout + (long)row * DM + i * 256 + lane * 4) = o;
    }
  }
}

struct RowLinear { long ld; DI long operator()(int r) const { return (long)r * ld; } };
struct RowCmp { int off; DI long operator()(int r) const { const int g = r & 3, n = (r >> 2) & 127, b = r >> 9; return ((long)b * T + n * 16) * LDO + off + g * 64; } };
DI void store_bf4(bf16_t* dst, f32x4 v) { u32x2 w; w.x = pk2(v[0], v[1]); w.y = pk2(v[2], v[3]); *(u32x2*)dst = w; }

template <class RowMap, class Epi>
DI void gemm_tile128(char* smem, int tid, const bf16_t* A, RowMap rowmap, int a_kstep, const bf16_t* Bt, int ldb, int mt, int KT, Epi epi) {
  const int lane = tid & 63, wid = tid >> 6, wr = wid >> 1, wc = wid & 1, fr = lane & 15, fq = lane >> 4;
  bf16_t* sA = (bf16_t*)smem;
  bf16_t* sB = sA + 128 * 72;
  const bf16_t* ap[4]; const bf16_t* bp[4];
#pragma unroll
  for (int i = 0; i < 4; ++i) {
    const int c = tid + i * 256, r = c >> 3, cc = (c & 7) * 8;
    ap[i] = A + rowmap(mt * 128 + r) + cc;
    bp[i] = Bt + (long)r * ldb + cc;
  }
  f32x4 acc[4][4];
#pragma unroll
  for (int m = 0; m < 4; ++m)
#pragma unroll
    for (int n = 0; n < 4; ++n) acc[m][n] = (f32x4){0.f, 0.f, 0.f, 0.f};
  u32x4 ra[2][4], rb[2][4];
#pragma unroll
  for (int s = 0; s < 2; ++s)
    if (s < KT) {
#pragma unroll
      for (int i = 0; i < 4; ++i) { ra[s][i] = *(const u32x4*)(ap[i] + (long)s * a_kstep); rb[s][i] = *(const u32x4*)(bp[i] + s * 64); }
    }
  for (int kt3 = 0; kt3 < KT; kt3 += 2) {
#pragma unroll
    for (int s = 0; s < 2; ++s) {
      const int kt = kt3 + s;
      if (kt < KT) {
        __syncthreads();
#pragma unroll
        for (int i = 0; i < 4; ++i) {
          const int c = tid + i * 256, r = c >> 3, cc = (c & 7) * 8;
          *(u32x4*)(sA + r * 72 + cc) = ra[s][i];
          *(u32x4*)(sB + r * 72 + cc) = rb[s][i];
        }
        __syncthreads();
        if (kt + 2 < KT) {
#pragma unroll
          for (int i = 0; i < 4; ++i) { ra[s][i] = *(const u32x4*)(ap[i] + (long)(kt + 2) * a_kstep); rb[s][i] = *(const u32x4*)(bp[i] + (kt + 2) * 64); }
        }
#pragma unroll
        for (int ks = 0; ks < 2; ++ks) {
          bf16x8 af[4], bfr[4];
#pragma unroll
          for (int m = 0; m < 4; ++m) af[m] = *(const bf16x8*)(sA + (wr * 64 + m * 16 + fr) * 72 + ks * 32 + fq * 8);
#pragma unroll
          for (int n = 0; n < 4; ++n) bfr[n] = *(const bf16x8*)(sB + (wc * 64 + n * 16 + fr) * 72 + ks * 32 + fq * 8);
#pragma unroll
          for (int m = 0; m < 4; ++m)
#pragma unroll
            for (int n = 0; n < 4; ++n) acc[m][n] = mfma16(bfr[n], af[m], acc[m][n]);
        }
      }
    }
  }
  epi(acc, mt * 128 + wr * 64, wc * 64, lane);
}

struct EpiCmp1 {
  bf16_t* CH; const float* bias;
  DI void operator()(const f32x4 (&acc)[4][4], int row0, int col0, int lane) const {
    const int fr = lane & 15, fq = lane >> 4;
#pragma unroll
    for (int m = 0; m < 4; ++m)
#pragma unroll
      for (int n = 0; n < 4; ++n) {
        const f32x4 bv = *(const f32x4*)(bias + col0 + n * 16 + fq * 4);
        f32x4 o;
#pragma unroll
        for (int j = 0; j < 4; ++j) { const float x = acc[m][n][j] + bv[j]; o[j] = 0.5f * x * (1.0f + tanhf(0.7978845608028654f * (x + 0.044715f * x * x * x))); }
        store_bf4(CH + (long)(row0 + m * 16 + fr) * 128 + col0 + n * 16 + fq * 4, o);
      }
  }
};
struct EpiCmp2 {
  bf16_t* outp;
  DI void operator()(const f32x4 (&acc)[4][4], int row0, int col0, int lane) const {
    const int fr = lane & 15, fq = lane >> 4;
    if (col0 >= 64) return;
#pragma unroll
    for (int m = 0; m < 4; ++m) {
      const int row = row0 + m * 16 + fr;
      const bool dead = ((row >> 2) & 127) == 127;
#pragma unroll
      for (int n = 0; n < 4; ++n) store_bf4(outp + (long)row * 64 + col0 + n * 16 + fq * 4, dead ? (f32x4){0.f, 0.f, 0.f, 0.f} : acc[m][n]);
    }
  }
};

DI void cmp_phase(char* smem, const Params& p, int j) {
  const int t512 = otid(), half = t512 >> 8, tid = t512 & 255;
  if (obid() >= 64) return;
  const int tile = obid() * 2 + half, kv = tile >> 6, mt = tile & 63;
  char* sm = smem + half * 36864;
  if (kv == 0) gemm_tile128(sm, tid, p.Y, RowCmp{O_KC}, LDO, p.WC1 + (long)(j * 2 + 0) * 128 * 2048, 2048, mt, 32, EpiCmp1{p.CH, p.CB + (j * 2 + 0) * 128});
  else gemm_tile128(sm, tid, p.Y, RowCmp{O_VC}, LDO, p.WC1 + (long)(j * 2 + 1) * 128 * 2048, 2048, mt, 32, EpiCmp1{p.CH + 8192 * 128, p.CB + (j * 2 + 1) * 128});
  __threadfence();
  __syncthreads();
  if (kv == 0) gemm_tile128(sm, tid, p.CH, RowLinear{128}, 64, p.WC2 + (long)(j * 2 + 0) * 128 * 128, 128, mt, 2, EpiCmp2{p.KCMP});
  else gemm_tile128(sm, tid, p.CH + 8192 * 128, RowLinear{128}, 64, p.WC2 + (long)(j * 2 + 1) * 128 * 128, 128, mt, 2, EpiCmp2{p.VCMP});
}

namespace pg8 {
#define PG8_LAS __attribute__((address_space(3)))
constexpr int BM = 256, BK = 64, HALF = 128, HTB = HALF * BK * 2, STAGE_BYTES = 8 * HTB, NXCD = 8, WGM = 8;
__host__ __device__ __forceinline__ int lds_byte(int r, int c) { const int st = (r >> 4) * 2 + (c >> 5), rr = r & 15, cc = c & 31, ob = rr * 64 + cc * 2; return st * 1024 + (ob ^ (((ob >> 9) & 1) << 5)); }
__host__ __device__ __forceinline__ void stage_rc(int b, int& R, int& C) { const int st = b / 1024, sb = b % 1024, swz = sb ^ (((sb >> 9) & 1) << 5); R = (st >> 1) * 16 + swz / 64; C = (st & 1) * 32 + (swz % 64) / 2; }
__host__ __device__ __forceinline__ int perm32(int rho) { const int n = rho >> 4, i = rho & 15; return 8 * (i >> 2) + 4 * n + (i & 3); }
struct Unit { int pm, pn; };
struct Gemm { const bf16_t* A; const bf16_t* Bt; int M, N, K; };
struct StaticOrder {
    int nM, nN, nwg, G, c;
    __host__ __device__ void init(int M, int N, int G_, int c_) { nM = M / BM; nN = N / BM; nwg = nM * nN; G = G_; c = c_; }
    __host__ __device__ bool next(int i, Unit& u) const {
        const long L = (long)i * G + c; if (L >= nwg) return false;
        int wgid = (int)L; { const int q = nwg / NXCD, r = nwg % NXCD, xcd = wgid % NXCD, off = wgid / NXCD; wgid = (xcd < r ? xcd * (q + 1) : r * (q + 1) + (xcd - r) * q) + off; }
        const int nig = WGM * nN, gid = wgid / nig, fm = gid * WGM, gsz = (nM - fm) < WGM ? (nM - fm) : WGM;
        u.pm = fm + ((wgid % nig) % gsz); u.pn = (wgid % nig) / gsz; return true;
    }
    __device__ __forceinline__ void a_ready(const Unit&) const {}
    __device__ __forceinline__ void done(const Unit&) const {}
};
template <class Epi, class Sched, bool ALIGN_EPI = false, bool SP2 = false>
__device__ __forceinline__ void gemm_phase(PG8_LAS unsigned char* lds, const Gemm g, const Sched& S, const Epi& E) {
    const int tid = otid(), wid = __builtin_amdgcn_readfirstlane(tid >> 6), lane = tid & 63, wr = wid >> 2, wc = wid & 3, fr = lane & 15, fq = lane >> 4;
    const int K = g.K, nt = K / BK;
    unsigned voffA[2], voffB[2];
#pragma unroll
    for (int i = 0; i < 2; ++i) { int R, C; stage_rc(tid * 16 + i * 8192, R, C); const int Rb = Epi::PERM ? ((R & ~31) + perm32(R & 31)) : R;
        voffA[i] = (unsigned)(R * K + C) * 2u; voffB[i] = (unsigned)(Rb * K + C) * 2u; }
    const size_t kstep = (size_t)(BK * 2);
    const size_t hstep = (size_t)HALF * K * 2;
    const size_t tstep = 2 * hstep;
    const unsigned ldsw = (unsigned)wid * 1024u;
    const int aoff = lds_byte(wr * 64 + fr, fq * 8), boff = lds_byte(wc * 32 + fr, fq * 8);
#define PG8_SA(b, h) (((b) * 2 + (h)) * HTB)
#define PG8_SB(b, h) ((4 + (b) * 2 + (h)) * HTB)
#define PG8_STAGE(bufoff, gbase, voff) do { _Pragma("unroll") for (int _i = 0; _i < 2; ++_i) \
        __builtin_amdgcn_global_load_lds((const unsigned*)((const char*)(gbase) + (voff)[_i]), (PG8_LAS unsigned*)(lds + (bufoff) + ldsw + _i * 8192), 16, 0, 0); } while (0)
#define PG8_LDA(dst, b, h) do { _Pragma("unroll") for (int m = 0; m < 4; ++m) _Pragma("unroll") for (int k = 0; k < 2; ++k) dst[m][k] = *(const PG8_LAS bf16x8*)(lds + PG8_SA(b, h) + aoff + m * 2048 + k * 1024); } while (0)
#define PG8_LDB(dst, b, h) do { _Pragma("unroll") for (int n = 0; n < 2; ++n) _Pragma("unroll") for (int k = 0; k < 2; ++k) dst[n][k] = *(const PG8_LAS bf16x8*)(lds + PG8_SB(b, h) + boff + n * 2048 + k * 1024); } while (0)
#define PG8_MMA(ai, bj, At, Bt) do { __builtin_amdgcn_s_setprio(1); _Pragma("unroll") for (int m = 0; m < 4; ++m) _Pragma("unroll") for (int n = 0; n < 2; ++n) _Pragma("unroll") for (int k = 0; k < 2; ++k) \
        acc[ai][bj][m][n] = __builtin_amdgcn_mfma_f32_16x16x32_bf16(Bt[n][k], At[m][k], acc[ai][bj][m][n], 0, 0, 0); __builtin_amdgcn_s_setprio(0); } while (0)
#define PG8_WAIT_V(n) asm volatile("s_waitcnt vmcnt(" #n ")" ::: "memory")
#define PG8_WAIT_L(n) asm volatile("s_waitcnt lgkmcnt(" #n ")" ::: "memory")
#define PG8_BAR __builtin_amdgcn_s_barrier()
#define PG8_SCHED __builtin_amdgcn_sched_barrier(0)
    Unit cur, nxt; int ui = 0;
    if (!S.next(0, cur)) return;
    f32x4 acc[2][2][4][2];
#pragma unroll
    for (int a = 0; a < 2; ++a)
#pragma unroll
        for (int b = 0; b < 2; ++b)
#pragma unroll
            for (int m = 0; m < 4; ++m)
#pragma unroll
                for (int n = 0; n < 2; ++n) acc[a][b][m][n] = (f32x4){0.f, 0.f, 0.f, 0.f};
    bf16x8 At[4][2], B0[2][2], B1[2][2];
    const char* cA = (const char*)g.A + (size_t)cur.pm * tstep; const char* cB = (const char*)g.Bt + (size_t)cur.pn * tstep;
    S.a_ready(cur);
    if constexpr (SP2) {
        PG8_STAGE(PG8_SB(0, 0), cB, voffB); PG8_STAGE(PG8_SB(0, 1), cB + hstep, voffB); PG8_STAGE(PG8_SA(0, 0), cA, voffA); PG8_STAGE(PG8_SA(0, 1), cA + hstep, voffA);
        if (wr == 1) PG8_BAR;
        PG8_WAIT_V(2); PG8_BAR;
        PG8_STAGE(PG8_SB(1, 0), cB + kstep, voffB); PG8_STAGE(PG8_SA(1, 0), cA + kstep, voffA); PG8_STAGE(PG8_SB(1, 1), cB + hstep + kstep, voffB);
        PG8_WAIT_V(6); PG8_BAR;
    } else {
        PG8_STAGE(PG8_SB(0, 0), cB, voffB); PG8_STAGE(PG8_SA(0, 0), cA, voffA); PG8_STAGE(PG8_SB(0, 1), cB + hstep, voffB); PG8_STAGE(PG8_SA(0, 1), cA + hstep, voffA);
        if (wr == 1) PG8_BAR;
        PG8_WAIT_V(4); PG8_BAR;
        PG8_STAGE(PG8_SB(1, 0), cB + kstep, voffB); PG8_STAGE(PG8_SA(1, 0), cA + kstep, voffA); PG8_STAGE(PG8_SB(1, 1), cB + hstep + kstep, voffB);
        PG8_WAIT_V(6); PG8_BAR;
    }
    for (;;) {
        const bool has_next = S.next(ui + 1, nxt);
        const char* nA = has_next ? (const char*)g.A + (size_t)nxt.pm * tstep : cA; const char* nB = has_next ? (const char*)g.Bt + (size_t)nxt.pn * tstep : cB;
        for (int t = 0; t < nt; t += 2) {
            const bool last = (t == nt - 2);
            const char* a1 = cA + (size_t)(t + 1) * kstep;
            const char* a2 = last ? nA : cA + (size_t)(t + 2) * kstep; const char* b2 = last ? nB : cB + (size_t)(t + 2) * kstep;
            const char* a3 = a2 + kstep; const char* b3 = b2 + kstep;
            if (last && has_next) S.a_ready(nxt);
            if constexpr (SP2) {
            PG8_LDB(B0, 0, 0); PG8_LDB(B1, 0, 1); PG8_SCHED; PG8_LDA(At, 0, 0); PG8_STAGE(PG8_SA(1, 1), a1 + hstep, voffA);
            PG8_WAIT_V(8); PG8_WAIT_L(0); PG8_BAR; PG8_MMA(0, 0, At, B0); PG8_MMA(0, 1, At, B1); PG8_BAR; PG8_SCHED;
            PG8_LDA(At, 0, 1); PG8_STAGE(PG8_SB(0, 0), b2, voffB); PG8_STAGE(PG8_SB(0, 1), b2 + hstep, voffB); PG8_STAGE(PG8_SA(0, 0), a2, voffA);
            PG8_WAIT_V(8); PG8_WAIT_L(0); PG8_BAR; PG8_MMA(1, 0, At, B0); PG8_MMA(1, 1, At, B1); PG8_BAR; PG8_SCHED;
            PG8_LDB(B0, 1, 0); PG8_LDB(B1, 1, 1); PG8_SCHED; PG8_LDA(At, 1, 0); PG8_STAGE(PG8_SA(0, 1), a2 + hstep, voffA);
            PG8_WAIT_V(8); PG8_WAIT_L(0); PG8_BAR; PG8_MMA(0, 0, At, B0); PG8_MMA(0, 1, At, B1); PG8_BAR; PG8_SCHED;
            PG8_LDA(At, 1, 1); PG8_STAGE(PG8_SB(1, 0), b3, voffB); PG8_STAGE(PG8_SB(1, 1), b3 + hstep, voffB); PG8_STAGE(PG8_SA(1, 0), a3, voffA);
            PG8_WAIT_V(8); PG8_WAIT_L(0); PG8_BAR; PG8_MMA(1, 0, At, B0); PG8_MMA(1, 1, At, B1); PG8_BAR; PG8_SCHED;
            } else {
            PG8_LDB(B0, 0, 0); PG8_SCHED; PG8_LDA(At, 0, 0); PG8_STAGE(PG8_SA(1, 1), a1 + hstep, voffA);
            PG8_WAIT_L(8); PG8_BAR; PG8_WAIT_L(0); PG8_MMA(0, 0, At, B0); PG8_BAR; PG8_SCHED;
            PG8_LDB(B1, 0, 1); PG8_STAGE(PG8_SB(0, 0), b2, voffB);
            PG8_BAR; PG8_WAIT_L(0); PG8_MMA(0, 1, At, B1); PG8_BAR;
            PG8_LDA(At, 0, 1); PG8_STAGE(PG8_SA(0, 0), a2, voffA);
            PG8_BAR; PG8_WAIT_L(0); PG8_MMA(1, 0, At, B0); PG8_BAR; PG8_SCHED;
            PG8_STAGE(PG8_SB(0, 1), b2 + hstep, voffB);
            PG8_WAIT_V(6); PG8_BAR; PG8_MMA(1, 1, At, B1); PG8_BAR;
            PG8_LDB(B0, 1, 0); PG8_SCHED; PG8_LDA(At, 1, 0); PG8_STAGE(PG8_SA(0, 1), a2 + hstep, voffA);
            PG8_WAIT_L(8); PG8_BAR; PG8_WAIT_L(0); PG8_MMA(0, 0, At, B0); PG8_BAR; PG8_SCHED;
            PG8_LDB(B1, 1, 1); PG8_STAGE(PG8_SB(1, 0), b3, voffB);
            PG8_BAR; PG8_WAIT_L(0); PG8_MMA(0, 1, At, B1); PG8_BAR;
            PG8_LDA(At, 1, 1); PG8_STAGE(PG8_SA(1, 0), a3, voffA);
            PG8_BAR; PG8_WAIT_L(0); PG8_MMA(1, 0, At, B0); PG8_BAR; PG8_SCHED;
            PG8_STAGE(PG8_SB(1, 1), b3 + hstep, voffB);
            PG8_WAIT_V(6); PG8_BAR; PG8_MMA(1, 1, At, B1); PG8_BAR;
            }
        }
        if constexpr (ALIGN_EPI) { if (wr == 0) PG8_BAR; }
        if constexpr (!Epi::AFTER_DRAIN) { E(acc, cur, wr, wc, fr, fq); S.done(cur); }
        if (!has_next) break;
#pragma unroll
        for (int a = 0; a < 2; ++a)
#pragma unroll
            for (int b = 0; b < 2; ++b)
#pragma unroll
                for (int m = 0; m < 4; ++m)
#pragma unroll
                    for (int n = 0; n < 2; ++n) acc[a][b][m][n] = (f32x4){0.f, 0.f, 0.f, 0.f};
        cur = nxt; cA = nA; cB = nB; ++ui;
        if constexpr (ALIGN_EPI) { if (wr == 1) PG8_BAR; }
    }
    PG8_WAIT_V(0);
    if constexpr (!ALIGN_EPI) { if (wr == 0) PG8_BAR; }
    PG8_BAR;
    if constexpr (Epi::AFTER_DRAIN) { E.fused(acc, cur, wr, wc, fr, fq, lds, wid, lane); S.done(cur); }
#undef PG8_SA
#undef PG8_SB
#undef PG8_STAGE
#undef PG8_LDA
#undef PG8_LDB
#undef PG8_MMA
#undef PG8_WAIT_V
#undef PG8_WAIT_L
#undef PG8_BAR
#undef PG8_SCHED
}
}

struct EpiResid {
  static constexpr bool PERM = false, AFTER_DRAIN = false;
  const float* xin; float* xout;
  DI void operator()(const f32x4 (&acc)[2][2][4][2], const pg8::Unit& u, int wr, int wc, int fr_, int fq_) const {
    int fr = fr_, fq = fq_; asm volatile("" : "+v"(fr), "+v"(fq));
#pragma unroll
    for (int ai = 0; ai < 2; ++ai)
#pragma unroll
      for (int m = 0; m < 4; ++m) {
        const long rowoff = (long)(u.pm * 256 + ai * 128 + wr * 64 + m * 16 + fr) * DM + u.pn * 256 + wc * 32 + fq * 4;
#pragma unroll
        for (int bj = 0; bj < 2; ++bj)
#pragma unroll
          for (int n = 0; n < 2; ++n) {
            const long off = rowoff + bj * 128 + n * 16;
            *(f32x4*)(xout + off) = *(const f32x4*)(xin + off) + acc[ai][bj][m][n];
          }
      }
  }
};

struct EpiSwiglu {
  static constexpr bool PERM = false, AFTER_DRAIN = false;
  bf16_t* hid;
  DI void operator()(const f32x4 (&acc)[2][2][4][2], const pg8::Unit& u, int wr, int wc, int fr_, int fq_) const {
    int fr = fr_, fq = fq_; asm volatile("" : "+v"(fr), "+v"(fq));
#pragma unroll
    for (int ai = 0; ai < 2; ++ai)
#pragma unroll
      for (int m = 0; m < 4; ++m) {
        bf16_t* rowp = hid + (long)(u.pm * 256 + ai * 128 + wr * 64 + m * 16 + fr) * DFF + u.pn * 128 + wc * 16 + fq * 4;
#pragma unroll
        for (int bj = 0; bj < 2; ++bj) {
          f32x4 o;
#pragma unroll
          for (int j = 0; j < 4; ++j) { const float g = acc[ai][bj][m][0][j], uu = acc[ai][bj][m][1][j]; o[j] = g / (1.0f + __expf(-g)) * uu; }
          store_bf4(rowp + bj * 64, o);
        }
      }
  }
};

constexpr float QS_A = 0.10206207261596577f * LOG2E;
constexpr float QS_8 = 0.125f * LOG2E;

DI void rope_pair_store(bf16_t* d1, bf16_t* d2, f32x4 x1, f32x4 x2, const float* cosr, const float* sinr, float sc) {
  const f32x4 cs = *(const f32x4*)cosr, sn = *(const f32x4*)sinr;
  store_bf4(d1, (x1 * cs - x2 * sn) * sc);
  store_bf4(d2, (x2 * cs + x1 * sn) * sc);
}

struct EpiEven {
  static constexpr bool PERM = false, AFTER_DRAIN = false;
  bf16_t* Y; float* IW; const float* kv_gain; const float *cos64, *sin64, *cos32, *sin32; float* red;
  DI void operator()(const f32x4 (&acc)[2][2][4][2], const pg8::Unit& u, int wr, int wc, int fr_, int fq_) const {
    int fr = fr_, fq = fq_; asm volatile("" : "+v"(fr), "+v"(fq));
    if (u.pn == 3) {
#pragma unroll
      for (int ai = 0; ai < 2; ++ai)
#pragma unroll
        for (int m = 0; m < 4; ++m) {
          float ss = 0.f;
#pragma unroll
          for (int n = 0; n < 2; ++n)
#pragma unroll
            for (int j = 0; j < 4; ++j) ss += acc[ai][0][m][n][j] * acc[ai][0][m][n][j];
          ss += __shfl_xor(ss, 16); ss += __shfl_xor(ss, 32);
          if (fq == 0) red[wc * 256 + ai * 128 + wr * 64 + m * 16 + fr] = ss;
        }
      asm volatile("s_waitcnt lgkmcnt(0)" ::: "memory"); __builtin_amdgcn_s_barrier(); asm volatile("" ::: "memory");
#pragma unroll
      for (int ai = 0; ai < 2; ++ai)
#pragma unroll
        for (int m = 0; m < 4; ++m) {
          const int rl = ai * 128 + wr * 64 + m * 16 + fr;
          const float tot = (red[rl] + red[256 + rl]) + (red[512 + rl] + red[768 + rl]);
          const float rs = 1.0f / sqrtf(tot * (1.0f / 128.0f) + 1e-6f);
          bf16_t* dst = Y + (long)(u.pm * 256 + rl) * LDE + E_CKV + wc * 32 + fq * 4;
#pragma unroll
          for (int n = 0; n < 2; ++n) {
            const f32x4 gn = *(const f32x4*)(kv_gain + wc * 32 + n * 16 + fq * 4);
            store_bf4(dst + n * 16, acc[ai][0][m][n] * rs * gn);
          }
        }
    }
#pragma unroll
    for (int bj = 0; bj < 2; ++bj) {
      const int nc = u.pn * 256 + bj * 128 + wc * 32;
      if (nc >= E_CKV && nc < E_KROPE) continue;
#pragma unroll
      for (int ai = 0; ai < 2; ++ai)
#pragma unroll
        for (int m = 0; m < 4; ++m) {
          const int row = u.pm * 256 + ai * 128 + wr * 64 + m * 16 + fr, pos = row & (T - 1);
          bf16_t* yr = Y + (long)row * LDE;
          const f32x4 x1 = acc[ai][bj][m][0], x2 = acc[ai][bj][m][1];
          if (nc < E_QROPE) {
            store_bf4(yr + nc + fq * 4, x1); store_bf4(yr + nc + 16 + fq * 4, x2);
          } else if (nc < E_CKV) {
            rope_pair_store(yr + nc + fq * 4, yr + nc + 16 + fq * 4, x1, x2, cos32 + pos * 16 + fq * 4, sin32 + pos * 16 + fq * 4, QS_A);
          } else if (nc == E_KROPE) {
            rope_pair_store(yr + nc + fq * 4, yr + nc + 16 + fq * 4, x1, x2, cos32 + pos * 16 + fq * 4, sin32 + pos * 16 + fq * 4, 1.0f);
          } else if (nc < E_VB) {
            const int s0 = nc < E_QB ? E_IQ : E_QB, rel = nc - s0, hb = s0 + (rel & ~63), i0 = ((rel >> 5) & 1) * 16 + fq * 4;
            const float sc = (nc >= E_QB && nc < E_KB) ? QS_8 : 1.0f;
            rope_pair_store(yr + hb + i0, yr + hb + 32 + i0, x1, x2, cos64 + pos * 32 + i0, sin64 + pos * 32 + i0, sc);
          } else if (nc < E_IW) {
            store_bf4(yr + nc + fq * 4, x1); store_bf4(yr + nc + 16 + fq * 4, x2);
          } else {
            if (fq < 2) *(f32x4*)(IW + (long)row * 8 + fq * 4) = x1 * 0.35355339059327373f;
          }
          asm volatile("" ::: "memory");
        }
    }
  }
};

struct EpiOdd {
  static constexpr bool PERM = false, AFTER_DRAIN = false;
  bf16_t* Y; float* GATES; const float *cos64, *sin64;
  DI void operator()(const f32x4 (&acc)[2][2][4][2], const pg8::Unit& u, int wr, int wc, int fr_, int fq_) const {
    int fr = fr_, fq = fq_; asm volatile("" : "+v"(fr), "+v"(fq));
#pragma unroll
    for (int bj = 0; bj < 2; ++bj) {
      const int nc = u.pn * 256 + bj * 128 + wc * 32;
      if (nc >= 2624) continue;
#pragma unroll
      for (int ai = 0; ai < 2; ++ai)
#pragma unroll
        for (int m = 0; m < 4; ++m) {
          const int row = u.pm * 256 + ai * 128 + wr * 64 + m * 16 + fr, pos = row & (T - 1);
          bf16_t* yr = Y + (long)row * LDO;
          const f32x4 x1 = acc[ai][bj][m][0], x2 = acc[ai][bj][m][1];
          const int sec = nc < O_KC ? 0 : ((nc - O_KC) >> 8);
          if (nc < O_KC || (nc < O_G && (sec & 1) == 0)) {
            const int hb = nc & ~63, i0 = ((nc >> 5) & 1) * 16 + fq * 4;
            rope_pair_store(yr + hb + i0, yr + hb + 32 + i0, x1, x2, cos64 + pos * 32 + i0, sin64 + pos * 32 + i0, nc < O_KC ? QS_8 : 1.0f);
          } else if (nc < O_G) {
            store_bf4(yr + nc + fq * 4, x1); store_bf4(yr + nc + 16 + fq * 4, x2);
          } else {
            const int gc = nc - O_G;
            f32x4 o;
#pragma unroll
            for (int j = 0; j < 4; ++j) o[j] = 1.0f / (1.0f + __expf(-x1[j]));
            *(f32x4*)(GATES + (long)row * 48 + gc + fq * 4) = o;
            if (gc == 0) {
#pragma unroll
              for (int j = 0; j < 4; ++j) o[j] = 1.0f / (1.0f + __expf(-x2[j]));
              *(f32x4*)(GATES + (long)row * 48 + 16 + fq * 4) = o;
            }
          }
          asm volatile("" ::: "memory");
        }
    }
  }
};

template <class Epi>
DI void big_gemm(unsigned char* lds, const bf16_t* A, const bf16_t* Bt, int N, int K, const Epi& E) {
  pg8::Gemm g{A, Bt, NTOK, N, K};
  pg8::StaticOrder S; S.init(NTOK, N, (int)gridDim.x, obid());
  pg8::gemm_phase<Epi, pg8::StaticOrder, true, true>((PG8_LAS unsigned char*)lds, g, S, E);
}

DI int crow(int i, int h) { return (i & 3) + 8 * (i >> 2) + 4 * h; }
DI int vt_pos(int g4) { const int gi = g4 & 3; return (g4 >> 2) * 16 + (gi & 1) * 8 + (gi >> 1) * 4; }
DI void vt_write(bf16_t* sVt, int vst, int d0, int pos, const u32x4 (&kv)[4]) {
#pragma unroll
  for (int w = 0; w < 4; ++w) {
    u32x2 lo, hi;
    lo.x = (kv[0][w] & 0xffffu) | (kv[1][w] << 16); lo.y = (kv[2][w] & 0xffffu) | (kv[3][w] << 16);
    hi.x = (kv[0][w] >> 16) | (kv[1][w] & 0xffff0000u); hi.y = (kv[2][w] >> 16) | (kv[3][w] & 0xffff0000u);
    *(u32x2*)(sVt + (d0 + 2 * w) * vst + pos) = lo;
    *(u32x2*)(sVt + (d0 + 2 * w + 1) * vst + pos) = hi;
  }
}

DI void vt_write2(bf16_t* sVt, int vst, int d0, int pos, const u32x4 (&kv)[2]) {
#pragma unroll
  for (int w = 0; w < 4; ++w) {
    const unsigned lo = (kv[0][w] & 0xffffu) | (kv[1][w] << 16);
    const unsigned hi = (kv[0][w] >> 16) | (kv[1][w] & 0xffff0000u);
    *(unsigned*)(sVt + (d0 + 2 * w) * vst + pos) = lo;
    *(unsigned*)(sVt + (d0 + 2 * w + 1) * vst + pos) = hi;
  }
}
template <int NKS, int NDB, bool MASKED, class VF>
DI void flash_tile(f32x16 (&o)[NDB], f32x16& negref, float& mrun, float& l, const bf16x8 (&qf)[NKS], const bf16_t* sK, int kst, const bf16_t* sVt, int vst, VF valid) {
  const int lane = otid() & 63, r = lane & 31, h = lane >> 5;
  f32x16 s[2];
#pragma unroll
  for (int kb = 0; kb < 2; ++kb) {
#pragma unroll
    for (int ks = 0; ks < NKS; ++ks) {
      const bf16x8 a = *(const bf16x8*)(sK + (kb * 32 + r) * kst + ks * 16 + h * 8);
      if (ks == 0) s[kb] = mfma32(a, qf[0], negref); else s[kb] = mfma32(a, qf[ks], s[kb]);
    }
    __builtin_amdgcn_sched_barrier(0);
  }
  float mx = NEG_INF;
#pragma unroll
  for (int kb = 0; kb < 2; ++kb)
#pragma unroll
    for (int i = 0; i < 16; ++i) {
      if (MASKED) { const float sv = valid(kb, i) ? s[kb][i] : NEG_INF; s[kb][i] = sv; }
      mx = fmaxf(mx, s[kb][i]);
    }
  mx = fmaxf(mx, __shfl_xor(mx, 32));
  float mr = fmaxf(mrun, mx);
  const bool need = (mr > 8.0f) || (mr < -8.0f && mr != NEG_INF);
  if (__ballot(need) != 0ull) {
    const float delta = need ? mr : 0.f;
    const float alpha = ex2(-delta);
#pragma unroll
    for (int kb = 0; kb < 2; ++kb)
#pragma unroll
      for (int i = 0; i < 16; ++i) s[kb][i] -= delta;
#pragma unroll
    for (int db = 0; db < NDB; ++db)
#pragma unroll
      for (int i = 0; i < 16; ++i) o[db][i] *= alpha;
#pragma unroll
    for (int i = 0; i < 16; ++i) negref[i] -= delta;
    l *= alpha;
    mr -= delta;
  }
  mrun = mr;
  float ps = 0.f;
#pragma unroll
  for (int kb = 0; kb < 2; ++kb)
#pragma unroll
    for (int i = 0; i < 16; ++i) { const float pv = ex2(s[kb][i]); s[kb][i] = pv; ps += pv; }
  l += ps;
  __builtin_amdgcn_sched_barrier(0);
#pragma unroll
  for (int kb = 0; kb < 2; ++kb)
#pragma unroll
    for (int s2 = 0; s2 < 2; ++s2) {
      u32x4 pw;
#pragma unroll
      for (int jj = 0; jj < 4; ++jj) pw[jj] = pk2(s[kb][8 * s2 + 2 * jj], s[kb][8 * s2 + 2 * jj + 1]);
      const bf16x8 pf = __builtin_bit_cast(bf16x8, pw);
#pragma unroll
      for (int db = 0; db < NDB; ++db) {
        const bf16x8 a = *(const bf16x8*)(sVt + (db * 32 + r) * vst + kb * 32 + s2 * 16 + h * 8);
        o[db] = mfma32(a, pf, o[db]);
      }
      __builtin_amdgcn_sched_barrier(0);
    }
}
template <int NKS, int NDB, int MASKED, class VF, bool REFC = true>
DI void qk_softmax(u32x4 (&pw)[4], f32x16 (&o)[NDB], f32x16& negref, float& mrun, float& l, const bf16x8 (&qf)[NKS], const bf16_t* sK, int kst, VF valid, bool rowok = true) {
  const int lane = otid() & 63, r = lane & 31, h = lane >> 5;
  f32x16 s[2];
  constexpr int KG = 2;
#pragma unroll
  for (int k0 = 0; k0 < NKS; k0 += KG) {
    bf16x8 a[2][KG];
#pragma unroll
    for (int kb = 0; kb < 2; ++kb)
#pragma unroll
      for (int kk = 0; kk < KG; ++kk)
        if (k0 + kk < NKS) a[kb][kk] = *(const bf16x8*)(sK + (kb * 32 + r) * kst + (k0 + kk) * 16 + h * 8);
    __builtin_amdgcn_sched_group_barrier(0x100, 2 * KG, 0);
#pragma unroll
    for (int kk = 0; kk < KG; ++kk)
#pragma unroll
      for (int kb = 0; kb < 2; ++kb)
        if (k0 + kk < NKS) {
          if (k0 + kk == 0) {
            if (REFC) s[kb] = mfma32(a[kb][kk], qf[0], negref);
            else { f32x16 z; _Pragma("unroll") for (int i_ = 0; i_ < 16; ++i_) z[i_] = 0.f; s[kb] = mfma32(a[kb][kk], qf[0], z); }
          } else s[kb] = mfma32(a[kb][kk], qf[k0 + kk], s[kb]);
        }
    __builtin_amdgcn_sched_group_barrier(0x008, 2 * KG, 0);
  }
  if (!REFC) {
#pragma unroll
    for (int kb = 0; kb < 2; ++kb)
#pragma unroll
      for (int i = 0; i < 16; ++i) s[kb][i] += negref[0];
  }
  float mx = NEG_INF;
#pragma unroll
  for (int kb = 0; kb < 2; ++kb)
#pragma unroll
    for (int i = 0; i < 16; ++i) {
      if (MASKED == 1) { const float sv = valid(kb, i) ? s[kb][i] : NEG_INF; s[kb][i] = sv; }
      mx = fmaxf(mx, s[kb][i]);
    }
  if (MASKED == 2) mx = rowok ? mx : NEG_INF;
  mx = fmaxf(mx, __shfl_xor(mx, 32));
  float mr = fmaxf(mrun, mx);
  const bool need = (mr > 8.0f) || (mr < -8.0f && mr != NEG_INF);
  if (__ballot(need) != 0ull) {
    const float delta = need ? mr : 0.f;
    const float alpha = ex2(-delta);
#pragma unroll
    for (int kb = 0; kb < 2; ++kb)
#pragma unroll
      for (int i = 0; i < 16; ++i) s[kb][i] -= delta;
#pragma unroll
    for (int db = 0; db < NDB; ++db)
#pragma unroll
      for (int i = 0; i < 16; ++i) o[db][i] *= alpha;
#pragma unroll
    for (int i = 0; i < 16; ++i) negref[i] -= delta;
    l *= alpha;
    mr -= delta;
  }
  mrun = mr;
  float ps = 0.f;
#pragma unroll
  for (int kb = 0; kb < 2; ++kb)
#pragma unroll
    for (int i = 0; i < 16; ++i) { const float pv = ex2(s[kb][i]); s[kb][i] = pv; ps += pv; }
  if (MASKED == 2) ps = rowok ? ps : 0.f;
  l += ps;
#pragma unroll
  for (int kb = 0; kb < 2; ++kb)
#pragma unroll
    for (int s2 = 0; s2 < 2; ++s2)
#pragma unroll
      for (int jj = 0; jj < 4; ++jj) {
        const unsigned w = pk2(s[kb][8 * s2 + 2 * jj], s[kb][8 * s2 + 2 * jj + 1]);
        pw[kb * 2 + s2][jj] = (MASKED == 2) ? (rowok ? w : 0u) : w;
      }
}
template <int NKS, int NDB, int MASKED, class VF>
DI void qk_softmax_s(u32x4 (&pw)[4], f32x16 (&o)[NDB], f32x16& negref, float& mrun, float& l, const bf16x8 (&qf)[NKS], const bf16_t* sK, int kst, VF valid) {
  qk_softmax<NKS, NDB, MASKED, VF, true>(pw, o, negref, mrun, l, qf, sK, kst, valid);
}
template <int NDB>
DI void pv_tile(f32x16 (&o)[NDB], const u32x4 (&pw)[4], const bf16_t* sVt, int vst) {
  const int lane = otid() & 63, r = lane & 31, h = lane >> 5;
#pragma unroll
  for (int kb = 0; kb < 2; ++kb)
#pragma unroll
    for (int s2 = 0; s2 < 2; ++s2) {
      const bf16x8 pf = __builtin_bit_cast(bf16x8, pw[kb * 2 + s2]);
      bf16x8 a[NDB];
#pragma unroll
      for (int db = 0; db < NDB; ++db) a[db] = *(const bf16x8*)(sVt + (db * 32 + r) * vst + kb * 32 + s2 * 16 + h * 8);
      __builtin_amdgcn_sched_group_barrier(0x100, NDB, 0);
#pragma unroll
      for (int db = 0; db < NDB; ++db) o[db] = mfma32(a[db], pf, o[db]);
      __builtin_amdgcn_sched_group_barrier(0x008, NDB, 0);
    }
}
DI bool wave_skew(int wid) { return (((wid & 1) ^ (wid >> 2)) & 1) != 0; }

#define FLASH_STATE(NDB) f32x16 o[NDB]; f32x16 negref; float mrun = NEG_INF, l = 0.f; \
  _Pragma("unroll") for (int i_ = 0; i_ < 16; ++i_) { negref[i_] = 0.f; _Pragma("unroll") for (int db_ = 0; db_ < NDB; ++db_) o[db_][i_] = 0.f; }

DI void idx_phase(char* smem, const Params& p) {
  const int tid = otid(), lane = tid & 63, wid = tid >> 6, fr = lane & 15, fq = lane >> 4;
  unsigned* hw = (unsigned*)smem + wid * 2048;
  float* scr = p.SCR + (long)obid() * 16 * 2048;
  for (int rnd = 0; rnd * (int)gridDim.x < NB * 128; ++rnd) {
    const int it = rnd * (int)gridDim.x + ((rnd & 1) ? ((int)gridDim.x - 1 - obid()) : obid());
    if (it >= NB * 128) break;
    const int qt = 127 - it / NB, b = it % NB, q0 = qt * 16;
    const bf16_t* yb = p.Y + (long)b * T * LDE;
    bf16x8 qf[8][2];
#pragma unroll
    for (int hh = 0; hh < 8; ++hh)
#pragma unroll
      for (int ks = 0; ks < 2; ++ks) qf[hh][ks] = *(const bf16x8*)(yb + (long)(q0 + fr) * LDE + E_IQ + hh * 64 + ks * 32 + fq * 8);
    float w[8];
    {
      const f32x4 w0 = *(const f32x4*)(p.IW + ((long)b * T + q0 + fr) * 8), w1 = *(const f32x4*)(p.IW + ((long)b * T + q0 + fr) * 8 + 4);
      w[0] = w0[0]; w[1] = w0[1]; w[2] = w0[2]; w[3] = w0[3]; w[4] = w1[0]; w[5] = w1[1]; w[6] = w1[2]; w[7] = w1[3];
    }
    __syncthreads();
    {
      const bf16_t* kbase = yb + (long)fr * LDE + E_IK + fq * 8;
      bf16x8 kf[2], nf[2];
      int kt = wid;
      if (kt <= qt) { kf[0] = *(const bf16x8*)(kbase + (long)(kt * 16) * LDE); kf[1] = *(const bf16x8*)(kbase + (long)(kt * 16) * LDE + 32); }
      for (; kt <= qt; kt += 8) {
        if (kt + 8 <= qt) { nf[0] = *(const bf16x8*)(kbase + (long)((kt + 8) * 16) * LDE); nf[1] = *(const bf16x8*)(kbase + (long)((kt + 8) * 16) * LDE + 32); }
        f32x4 sc = {0.f, 0.f, 0.f, 0.f};
#pragma unroll
        for (int hh = 0; hh < 8; ++hh) {
          f32x4 a = {0.f, 0.f, 0.f, 0.f};
          a = mfma16(kf[0], qf[hh][0], a);
          a = mfma16(kf[1], qf[hh][1], a);
#pragma unroll
          for (int j = 0; j < 4; ++j) sc[j] += fmaxf(a[j], 0.f) * w[hh];
        }
        *(f32x4*)(scr + fr * 2048 + kt * 16 + fq * 4) = sc;
        kf[0] = nf[0]; kf[1] = nf[1];
      }
    }
    __syncthreads();
#pragma unroll 1
    for (int qq = 0; qq < 2; ++qq) {
      const int ql = wid * 2 + qq, t = q0 + ql;
      u64* outw = p.SEL + ((long)b * T + t) * 32;
      if (t < 256) {
        if (lane < 32) { const int lo = lane * 64; outw[lane] = (t >= lo + 63) ? ~0ull : (t < lo ? 0ull : ((1ull << (t - lo + 1)) - 1ull)); }
        continue;
      }
      const int ne = (t >> 6) + 1;
      unsigned key[32];
      float sv[32];
#pragma unroll
      for (int e = 0; e < 32; ++e) sv[e] = scr[ql * 2048 + e * 64 + lane];
#pragma unroll
      for (int e = 0; e < 32; ++e) {
        const int s = e * 64 + lane;
        const float v = sv[e] + 0.0f;
        unsigned u = __float_as_uint(v);
        u = (u & 0x80000000u) ? ~u : (u | 0x80000000u);
        key[e] = (s <= t) ? u : 0u;
      }
      unsigned prefix = 0; unsigned kk = 256; int sh = 32; bool whole = false;
#pragma unroll 1
      for (int pass = 0; pass < 4; ++pass) {
        const int shift = 24 - 8 * pass;
#pragma unroll
        for (int k = 0; k < 8; ++k) *(u32x4*)(hw + lane * 4 + k * 256) = (u32x4){0u, 0u, 0u, 0u};
#pragma unroll
        for (int e = 0; e < 32; ++e) {
          if (e < ne) {
            const unsigned u = key[e];
            const bool match = (pass == 0) || ((u >> (shift + 8)) == prefix);
            if (match) atomicAdd(hw + ((u >> shift) & 255u) * 8 + (lane & 7), 1u);
          }
        }
        u32x4 c;
#pragma unroll
        for (int bb = 0; bb < 4; ++bb) {
          const u32x4 s0 = *(const u32x4*)(hw + lane * 32 + bb * 8), s1 = *(const u32x4*)(hw + lane * 32 + bb * 8 + 4);
          c[bb] = ((s0[0] + s0[1]) + (s0[2] + s0[3])) + ((s1[0] + s1[1]) + (s1[2] + s1[3]));
        }
        const unsigned S = c[0] + c[1] + c[2] + c[3];
        unsigned Tl = S;
#pragma unroll
        for (int off = 1; off < 64; off <<= 1) { const unsigned v = __shfl_down(Tl, off); if (lane + off < 64) Tl += v; }
        unsigned a = Tl - S; int found = -1; unsigned nk = 0, cb = 0;
        if (a < kk && a + c[3] >= kk) { found = 3; nk = kk - a; cb = c[3]; } a += c[3];
        if (found < 0 && a < kk && a + c[2] >= kk) { found = 2; nk = kk - a; cb = c[2]; } a += c[2];
        if (found < 0 && a < kk && a + c[1] >= kk) { found = 1; nk = kk - a; cb = c[1]; } a += c[1];
        if (found < 0 && a < kk && a + c[0] >= kk) { found = 0; nk = kk - a; cb = c[0]; }
        const u64 bal = __ballot(found >= 0);
        const int src = __ffsll((long long)bal) - 1;
        const unsigned digit = (unsigned)__shfl(lane * 4 + found, src);
        kk = (unsigned)__shfl((int)nk, src);
        const unsigned cbin = (unsigned)__shfl((int)cb, src);
        prefix = (prefix << 8) | digit;
        sh = shift;
        if (cbin == kk) { whole = true; break; }
      }
      unsigned run = 0; u64 myword = 0;
      if (whole) {
#pragma unroll
        for (int e = 0; e < 32; ++e) {
          if (e < ne) {
            const u64 wsel = __ballot((key[e] >> sh) >= prefix);
            if (lane == e) myword = wsel;
          }
        }
      } else
#pragma unroll
      for (int e = 0; e < 32; ++e) {
        if (e < ne) {
          const unsigned u = key[e] >> sh;
          const bool eq = (u == prefix);
          const u64 be = __ballot(eq);
          const unsigned rank = run + (unsigned)__popcll(be & ((1ull << lane) - 1ull));
          const bool selb = (u > prefix) || (eq && rank < kk);
          const u64 wsel = __ballot(selb);
          run += (unsigned)__popcll(be);
          if (lane == e) myword = wsel;
        }
      }
      if (lane < 32) outw[lane] = myword;
    }
  }
}

constexpr int DSA_BUF = 39936;
DI void dsa_phase(char* smem, const Params& p, int j) {
  bf16_t* sK = (bf16_t*)smem;
  bf16_t* sVt = sK + 64 * 168;
  const int tid = otid(), lane = tid & 63, wid = tid >> 6, r = lane & 31, h = lane >> 5;
  const bool ldv = tid < 256, skew = wave_skew(wid);
  for (int rnd = 0; rnd * (int)gridDim.x < NB * 64; ++rnd) {
    const int it = rnd * (int)gridDim.x + ((rnd & 1) ? ((int)gridDim.x - 1 - obid()) : obid());
    if (it >= NB * 64) break;
    const int qt = 63 - it / NB, b = it % NB;
    const int tl = otid();
    const int g4 = tl & 15, dg = (tl >> 4) & 15, rk = (tl & 255) >> 2, rc = tl & 3;
    const int head = wid, q0 = qt * 32, tq = q0 + r;
    const bf16_t* yb = p.Y + (long)b * T * LDE;
    bf16x8 qf[10];
    {
      bf16x8 qn[4];
#pragma unroll
      for (int ks = 0; ks < 4; ++ks) qn[ks] = *(const bf16x8*)(yb + (long)tq * LDE + E_QNOPE + head * 64 + ks * 16 + h * 8);
      const bf16_t* wuk = p.WUKT + ((long)(j * 8 + head) * 128 + r) * 64 + h * 8;
#pragma unroll
      for (int cb = 0; cb < 4; ++cb) {
        int cbo = cb * 32 * 64;
        asm volatile("" : "+v"(cbo));
        const bf16_t* wk = wuk + cbo;
        f32x16 ql;
#pragma unroll
        for (int i = 0; i < 16; ++i) ql[i] = 0.f;
#pragma unroll
        for (int ks = 0; ks < 4; ++ks) { const bf16x8 a = *(const bf16x8*)(wk + ks * 16); ql = mfma32(a, qn[ks], ql); }
#pragma unroll
        for (int s2 = 0; s2 < 2; ++s2) {
          u32x4 w;
#pragma unroll
          for (int jj = 0; jj < 4; ++jj) w[jj] = pk2(ql[8 * s2 + 2 * jj] * QS_A, ql[8 * s2 + 2 * jj + 1] * QS_A);
          qf[cb * 2 + s2] = __builtin_bit_cast(bf16x8, w);
        }
        __builtin_amdgcn_sched_barrier(0);
      }
    }
    __builtin_amdgcn_sched_barrier(0);
    int tq2 = tq; asm volatile("" : "+v"(tq2));
#pragma unroll
    for (int ks = 0; ks < 2; ++ks) qf[8 + ks] = *(const bf16x8*)(yb + (long)tq2 * LDE + E_QROPE + head * 32 + ks * 16 + h * 8);
    const u64* selrow = p.SEL + ((long)b * T + tq2) * 32;
    FLASH_STATE(4)
    const int nkt = ((q0 + 31) >> 6) + 1;
    u32x4 kv[4];
    auto issue = [&](int kt) {
      const bf16_t* base = yb + (long)(kt * 64) * LDE + E_CKV;
      if (ldv) {
#pragma unroll
        for (int i = 0; i < 4; ++i) kv[i] = *(const u32x4*)(base + (long)(g4 * 4 + i) * LDE + dg * 8);
      } else kv[0] = *(const u32x4*)(base + (long)rk * LDE + 128 + rc * 8);
    };
    auto stash = [&](int buf) {
      bf16_t* bK = sK + buf * (DSA_BUF / 2); bf16_t* bV = sVt + buf * (DSA_BUF / 2);
      if (ldv) {
#pragma unroll
        for (int i = 0; i < 4; ++i) {
          bf16_t* rowp = bK + (g4 * 4 + i) * 168 + (dg >> 1) * 16 + (dg & 1) * 4;
          *(u32x2*)rowp = (u32x2){kv[i][0], kv[i][1]};
          *(u32x2*)(rowp + 8) = (u32x2){kv[i][2], kv[i][3]};
        }
        vt_write(bV, 72, dg * 8, vt_pos(g4), kv);
      } else *(u32x4*)(bK + rk * 168 + 128 + rc * 8) = kv[0];
    };
    issue(0);
    __syncthreads();
    stash(0);
    if (nkt > 1) issue(1);
    __syncthreads();
    u32x4 pw[4];
    u64 word = selrow[0];
    for (int kt = 0; kt < nkt; ++kt) {
      const int buf = kt % 3;
      const u64 wnext = selrow[kt + 1 < nkt ? kt + 1 : kt];
      const unsigned wlo = (unsigned)word >> (4 * h), whi = (unsigned)(word >> 32) >> (4 * h);
      if (skew) {
        if (kt > 0) pv_tile<4>(o, pw, sVt + ((kt - 1) % 3) * (DSA_BUF / 2), 72);
        qk_softmax_s<10, 4, 1>(pw, o, negref, mrun, l, qf, sK + buf * (DSA_BUF / 2), 168, [&](int kb, int i) { return (((kb ? whi : wlo) >> ((i & 3) + 8 * (i >> 2))) & 1u) != 0u; });
      } else {
        qk_softmax_s<10, 4, 1>(pw, o, negref, mrun, l, qf, sK + buf * (DSA_BUF / 2), 168, [&](int kb, int i) { return (((kb ? whi : wlo) >> ((i & 3) + 8 * (i >> 2))) & 1u) != 0u; });
        pv_tile<4>(o, pw, sVt + buf * (DSA_BUF / 2), 72);
      }
      word = wnext;
      if (kt + 1 < nkt) {
        stash((kt + 1) % 3);
        if (kt + 2 < nkt) issue(kt + 2);
        __syncthreads();
      }
    }
    if (skew) pv_tile<4>(o, pw, sVt + ((nkt - 1) % 3) * (DSA_BUF / 2), 72);
    l += __shfl_xor(l, 32);
    const float inv = l > 0.f ? 1.0f / l : 0.f;
    u32x4 pwv[8];
#pragma unroll
    for (int db = 0; db < 4; ++db)
#pragma unroll
      for (int s2 = 0; s2 < 2; ++s2)
#pragma unroll
        for (int jj = 0; jj < 4; ++jj) pwv[db * 2 + s2][jj] = pk2(o[db][8 * s2 + 2 * jj] * inv, o[db][8 * s2 + 2 * jj + 1] * inv);
    asm volatile("" ::: "memory");
    int r2 = r, h2 = h, head2 = head, b2 = b; asm volatile("" : "+v"(r2), "+v"(h2), "+v"(head2), "+s"(b2));
    const bf16_t* wuv = p.WUVP + ((long)(j * 8 + head2) * 64 + r2) * 128 + h2 * 8;
    f32x16 oo[2];
#pragma unroll
    for (int dblk = 0; dblk < 2; ++dblk) {
#pragma unroll
      for (int i = 0; i < 16; ++i) oo[dblk][i] = 0.f;
#pragma unroll
      for (int ks = 0; ks < 8; ++ks) {
        const bf16x8 a = *(const bf16x8*)(wuv + (long)dblk * 32 * 128 + ks * 16);
        oo[dblk] = mfma32(a, __builtin_bit_cast(bf16x8, pwv[ks]), oo[dblk]);
      }
    }
    bf16_t* orow = p.O + ((long)b2 * T + q0 + r2) * DM + head2 * 64;
#pragma unroll
    for (int dblk = 0; dblk < 2; ++dblk)
#pragma unroll
      for (int g = 0; g < 4; ++g)
        store_bf4(orow + dblk * 32 + 8 * g + 4 * h2, (f32x4){oo[dblk][4 * g], oo[dblk][4 * g + 1], oo[dblk][4 * g + 2], oo[dblk][4 * g + 3]});
  }
}

constexpr int DIFF_BUF = 35840;
DI void diff_phase(char* smem, const Params& p, int j, float lam_init) {
  bf16_t* sK = (bf16_t*)smem;
  bf16_t* sVt = sK + 64 * 136;
  float* cbuf = (float*)smem;
  const int tid = otid(), lane = tid & 63, wid = tid >> 6, r = lane & 31, h = lane >> 5, mp = wid >> 2, qs = wid & 3;
  const int g4 = tid & 15, dg = (tid >> 4) & 15, t2 = tid & 255;
  const bool ldv = tid < 256, skew = wave_skew(wid);
  float lam;
  {
    const float* lf = p.ev_lambda + j * 256;
    float d01 = lf[lane] * lf[64 + lane], d23 = lf[128 + lane] * lf[192 + lane];
#pragma unroll
    for (int off = 32; off >= 1; off >>= 1) { d01 += __shfl_xor(d01, off); d23 += __shfl_xor(d23, off); }
    lam = expf(d01) - expf(d23) + lam_init;
  }
  const float* subln = p.ev_subln + j * 128;
  for (int rnd = 0; rnd * (int)gridDim.x < NB * 4 * 16; ++rnd) {
    const int it = rnd * (int)gridDim.x + ((rnd & 1) ? ((int)gridDim.x - 1 - obid()) : obid());
    if (it >= NB * 4 * 16) break;
    const int qt = 15 - it / (NB * 4), rem = it % (NB * 4), b = rem >> 2, hd = rem & 3;
    const int q0 = qt * 128 + qs * 32, tq = q0 + r;
    const bf16_t* yb = p.Y + (long)b * T * LDE;
    bf16x8 qf[4];
#pragma unroll
    for (int ks = 0; ks < 4; ++ks) qf[ks] = *(const bf16x8*)(yb + (long)tq * LDE + E_QB + hd * 128 + mp * 64 + ks * 16 + h * 8);
    FLASH_STATE(4)
    const int nkt = 2 * qt + 2;
    u32x4 st[4];
    auto issue = [&](int kt) {
      const bf16_t* base = yb + (long)(kt * 64) * LDE;
      if (ldv) {
#pragma unroll
        for (int i = 0; i < 4; ++i) st[i] = *(const u32x4*)(base + (long)(g4 * 4 + i) * LDE + E_VB + hd * 128 + dg * 8);
      } else {
#pragma unroll
        for (int i = 0; i < 4; ++i) { const int c = t2 + i * 256; st[i] = *(const u32x4*)(base + (long)(c >> 4) * LDE + E_KB + hd * 128 + (c & 15) * 8); }
      }
    };
    auto stash = [&](int buf) {
      bf16_t* bK = sK + buf * (DIFF_BUF / 2); bf16_t* bV = sVt + buf * (DIFF_BUF / 2);
      if (ldv) vt_write(bV, 72, dg * 8, vt_pos(g4), st);
      else {
#pragma unroll
        for (int i = 0; i < 4; ++i) { const int c = t2 + i * 256; *(u32x4*)(bK + (c >> 4) * 136 + (c & 15) * 8) = st[i]; }
      }
    };
    issue(0);
    __syncthreads();
    stash(0);
    issue(1);
    __syncthreads();
    u32x4 pw[4]; bool havep = false; int pbuf = 0;
    for (int kt = 0; kt < nkt; ++kt) {
      const int buf = kt % 3;
      const bf16_t* bK = sK + buf * (DIFF_BUF / 2) + mp * 64; const bf16_t* bV = sVt + buf * (DIFF_BUF / 2);
      if (skew && havep) { pv_tile<4>(o, pw, sVt + pbuf * (DIFF_BUF / 2), 72); havep = false; }
      if (kt * 64 + 63 <= q0) {
        qk_softmax<4, 4, 0>(pw, o, negref, mrun, l, qf, bK, 136, [&](int kb, int i) { return true; });
        if (skew) { havep = true; pbuf = buf; } else pv_tile<4>(o, pw, bV, 72);
      } else if (kt * 64 <= q0 + 31) {
        const int lim = tq - kt * 64 - 4 * h;
        qk_softmax<4, 4, 1>(pw, o, negref, mrun, l, qf, bK, 136, [&](int kb, int i) { return kb * 32 + (i & 3) + 8 * (i >> 2) <= lim; });
        if (skew) { havep = true; pbuf = buf; } else pv_tile<4>(o, pw, bV, 72);
      }
      if (kt + 1 < nkt) {
        stash((kt + 1) % 3);
        if (kt + 2 < nkt) issue(kt + 2);
        __syncthreads();
      }
    }
    if (skew && havep) pv_tile<4>(o, pw, sVt + pbuf * (DIFF_BUF / 2), 72);
    l += __shfl_xor(l, 32);
    const float inv = l > 0.f ? 1.0f / l : 0.f;
    __syncthreads();
    if (mp == 1) {
#pragma unroll
      for (int db = 0; db < 4; ++db)
#pragma unroll
        for (int g = 0; g < 4; ++g)
          *(f32x4*)(cbuf + (qs * 32 + r) * 132 + db * 32 + 8 * g + 4 * h) = (f32x4){o[db][4 * g] * inv, o[db][4 * g + 1] * inv, o[db][4 * g + 2] * inv, o[db][4 * g + 3] * inv};
    }
    __syncthreads();
    if (mp == 0) {
      float ss = 0.f;
#pragma unroll
      for (int db = 0; db < 4; ++db)
#pragma unroll
        for (int g = 0; g < 4; ++g) {
          const f32x4 o1 = *(const f32x4*)(cbuf + (qs * 32 + r) * 132 + db * 32 + 8 * g + 4 * h);
#pragma unroll
          for (int jj = 0; jj < 4; ++jj) { const float a = o[db][4 * g + jj] * inv - lam * o1[jj]; o[db][4 * g + jj] = a; ss += a * a; }
        }
      ss += __shfl_xor(ss, 32);
      const float rs = (1.0f - lam_init) / sqrtf(ss * (1.0f / 128.0f) + 1e-6f);
      bf16_t* orow = p.O + ((long)b * T + tq) * DM + 512 + hd * 128;
#pragma unroll
      for (int db = 0; db < 4; ++db)
#pragma unroll
        for (int g = 0; g < 4; ++g) {
          const f32x4 sg = *(const f32x4*)(subln + db * 32 + 8 * g + 4 * h);
          store_bf4(orow + db * 32 + 8 * g + 4 * h, (f32x4){o[db][4 * g] * rs * sg[0], o[db][4 * g + 1] * rs * sg[1], o[db][4 * g + 2] * rs * sg[2], o[db][4 * g + 3] * rs * sg[3]});
        }
    }
  }
}

template <int MODE>
DI void nsa_branch(f32x16 (&tot)[2], float gate, unsigned tiles, const bf16x8 (&qf)[4], bf16_t* sK, bf16_t* sVt, const bf16_t* yb, int koff, int voff, int q0, int tq, unsigned mysel) {
  const int tid = otid(), lane = tid & 63, h = lane >> 5;
  const int g4 = tid & 15, dg = (tid >> 4) & 7, t2 = tid & 255;
  const bool ldv = tid < 128, ldk = tid >= 256;
  FLASH_STATE(2)
  unsigned rem = tiles;
  if (rem == 0u) return;
  u32x4 stA[2], stB[2];
  const int g2 = tid & 31, dg2 = (tid >> 5) & 7;
  const int vpos = vt_pos(g2 >> 1) + (g2 & 1) * 2;
  auto pop = [&]() { int r = -1; if (rem) { r = __ffs((int)rem) - 1; rem &= rem - 1u; } return r; };
  auto issue = [&](int jj, u32x4 (&st)[2]) {
    const bf16_t* base = yb + (long)(jj * 64) * LDO;
    if (tid < 256) {
#pragma unroll
      for (int i = 0; i < 2; ++i) st[i] = *(const u32x4*)(base + (long)(g2 * 2 + i) * LDO + voff + dg2 * 8);
    } else {
#pragma unroll
      for (int i = 0; i < 2; ++i) { const int c = t2 + i * 256; st[i] = *(const u32x4*)(base + (long)(c >> 3) * LDO + koff + (c & 7) * 8); }
    }
  };
  auto stash = [&](int buf, const u32x4 (&st)[2]) {
    if (tid < 256) vt_write2(sVt + buf * 4608, 72, dg2 * 8, vpos, st);
    else {
#pragma unroll
      for (int i = 0; i < 2; ++i) { const int c = t2 + i * 256; *(u32x4*)(sK + buf * 4608 + (c >> 3) * 72 + (c & 7) * 8) = st[i]; }
    }
  };
  u32x4 pw[4]; bool havep = false; int pbuf = 0;
  const bool skew = wave_skew(tid >> 6);
  int buf = 0;
  int j0 = pop(), j1 = pop(), j2 = pop();
  auto tile_step = [&](u32x4 (&st)[2]) {
    const int j = j0;
    const bf16_t* bK = sK + buf * 4608; const bf16_t* bV = sVt + buf * 4608;
    const int lim = tq - j * 64 - 4 * h;
    if (skew && havep) { pv_tile<2>(o, pw, sVt + pbuf * 4608, 72); havep = false; }
    bool done = false;
    if (MODE == 0) {
      const bool selb = ((mysel >> j) & 1u) != 0u;
      const unsigned long long bal = __ballot(selb);
      if (j * 64 <= q0 + 31 && bal != 0ull) {
        if (j * 64 + 63 <= q0 && bal == ~0ull)
          qk_softmax<4, 2, 0>(pw, o, negref, mrun, l, qf, bK, 72, [&](int kb, int i) { return true; });
        else if (j * 64 + 63 <= q0)
          qk_softmax<4, 2, 2>(pw, o, negref, mrun, l, qf, bK, 72, [&](int kb, int i) { return true; }, selb);
        else
          qk_softmax<4, 2, 1>(pw, o, negref, mrun, l, qf, bK, 72, [&](int kb, int i) { return selb && (kb * 32 + (i & 3) + 8 * (i >> 2) <= lim); });
        done = true;
      }
    } else {
      if (j * 64 <= q0 + 31 && j * 64 + 63 > q0 - 512) {
        if (j * 64 + 63 <= q0 && j * 64 > q0 + 31 - 512)
          qk_softmax<4, 2, 0>(pw, o, negref, mrun, l, qf, bK, 72, [&](int kb, int i) { return true; });
        else
          qk_softmax<4, 2, 1>(pw, o, negref, mrun, l, qf, bK, 72, [&](int kb, int i) { const int kk = kb * 32 + (i & 3) + 8 * (i >> 2); return kk <= lim && kk > lim - 512; });
        done = true;
      }
    }
    if (done) { if (skew) { havep = true; pbuf = buf; } else pv_tile<2>(o, pw, bV, 72); }
    if (j1 >= 0) {
      const int nbuf = buf == 2 ? 0 : buf + 1;
      stash(nbuf, st);
      const int j3 = pop();
      if (j3 >= 0) issue(j3, st);
      __syncthreads();
      buf = nbuf;
      j0 = j1; j1 = j2; j2 = j3;
    } else j0 = -1;
  };
  issue(j0, stA);
  __syncthreads();
  stash(0, stA);
  if (j1 >= 0) issue(j1, stB);
  if (j2 >= 0) issue(j2, stA);
  __syncthreads();
  while (j0 >= 0) {
    tile_step(stB);
    if (j0 >= 0) tile_step(stA);
  }
  if (skew && havep) pv_tile<2>(o, pw, sVt + pbuf * 4608, 72);
  l += __shfl_xor(l, 32);
  const float inv = l > 0.f ? gate / l : 0.f;
#pragma unroll
  for (int db = 0; db < 2; ++db)
#pragma unroll
    for (int i = 0; i < 16; ++i) tot[db][i] += o[db][i] * inv;
}

DI void nsa_phase(char* smem, const Params& p) {
  bf16_t* sK = (bf16_t*)smem;
  bf16_t* sVt = (bf16_t*)(smem + 18432);
  float* impb = (float*)(smem + 35840);
  float* imps = (float*)(smem + 69632);
  unsigned* selm = (unsigned*)(smem + 78080);
  const int tid = otid(), lane = tid & 63, wid = tid >> 6, r = lane & 31, h = lane >> 5, hh = wid & 3, qs = wid >> 2;
  for (int rnd = 0; rnd * (int)gridDim.x < NB * 32 * 4; ++rnd) {
    const int it = rnd * (int)gridDim.x + ((rnd & 1) ? ((int)gridDim.x - 1 - obid()) : obid());
    if (it >= NB * 32 * 4) break;
    const int qt = 31 - it / (NB * 4), rem = it % (NB * 4), b = rem >> 2, g = rem & 3;
    const int head = g * 4 + hh, q0 = qt * 64 + qs * 32, tq = q0 + r;
    const long tok = (long)b * T + tq;
    const bf16_t* yb = p.Y + (long)b * T * LDO;
    bf16x8 qf[4];
#pragma unroll
    for (int ks = 0; ks < 4; ++ks) qf[ks] = *(const bf16x8*)(yb + (long)tq * LDO + O_Q + head * 64 + ks * 16 + h * 8);
    const float g0 = p.GATES[tok * 48 + head * 3 + 0], g1 = p.GATES[tok * 48 + head * 3 + 1], g2 = p.GATES[tok * 48 + head * 3 + 2];
    __syncthreads();
    {
#pragma unroll
      for (int i = 0; i < 2; ++i) {
        const int c = tid + i * 512, row = c >> 3, cc = (c & 7) * 8;
        *(u32x4*)(sK + row * 72 + cc) = *(const u32x4*)(p.KCMP + ((long)(b * 128 + row) * 4 + g) * 64 + cc);
      }
      if (tid < 256) {
        const int g4 = tid & 31, dg = tid >> 5;
        u32x4 vv[4];
#pragma unroll
        for (int i = 0; i < 4; ++i) vv[i] = *(const u32x4*)(p.VCMP + ((long)(b * 128 + g4 * 4 + i) * 4 + g) * 64 + dg * 8);
        vt_write(sVt, 136, dg * 8, vt_pos(g4), vv);
      }
    }
    __syncthreads();
    f32x16 tot[2];
    {
      f32x16 s[4];
#pragma unroll
      for (int kb = 0; kb < 4; ++kb) {
#pragma unroll
        for (int i = 0; i < 16; ++i) s[kb][i] = 0.f;
#pragma unroll
        for (int ks = 0; ks < 4; ++ks) { const bf16x8 a = *(const bf16x8*)(sK + (kb * 32 + r) * 72 + ks * 16 + h * 8); s[kb] = mfma32(a, qf[ks], s[kb]); }
      }
      const int nlim = (tq >= 31 ? ((tq - 31) >> 4) : -1) - 4 * h;
      float mx = NEG_INF;
#pragma unroll
      for (int kb = 0; kb < 4; ++kb)
#pragma unroll
        for (int i = 0; i < 16; ++i) { const bool v = kb * 32 + (i & 3) + 8 * (i >> 2) <= nlim; const float sv = v ? s[kb][i] : NEG_INF; s[kb][i] = sv; mx = fmaxf(mx, sv); }
      mx = fmaxf(mx, __shfl_xor(mx, 32));
      const float muse = (mx == NEG_INF) ? 0.f : mx;
      float ps = 0.f;
#pragma unroll
      for (int kb = 0; kb < 4; ++kb)
#pragma unroll
        for (int i = 0; i < 16; ++i) { const float pv = ex2(s[kb][i] - muse); s[kb][i] = pv; ps += pv; }
      ps += __shfl_xor(ps, 32);
      const float inv = ps > 0.f ? 1.0f / ps : 0.f;
#pragma unroll
      for (int kb = 0; kb < 4; ++kb)
#pragma unroll
        for (int i = 0; i < 16; ++i) s[kb][i] *= inv;
      float part[4][4], recv[4][4];
#pragma unroll
      for (int kb = 0; kb < 4; ++kb)
#pragma unroll
        for (int g8 = 0; g8 < 4; ++g8) {
          part[kb][g8] = (s[kb][4 * g8] + s[kb][4 * g8 + 1]) + (s[kb][4 * g8 + 2] + s[kb][4 * g8 + 3]);
          recv[kb][g8] = __shfl_xor(s[kb][4 * g8 + 3], 32);
        }
#pragma unroll
      for (int kb = 0; kb < 4; ++kb)
#pragma unroll
        for (int g8 = 0; g8 < 4; ++g8) {
          float prev;
          if (h == 1) prev = recv[kb][g8];
          else prev = (g8 > 0) ? recv[kb][g8 - 1] : (kb > 0 ? recv[kb - 1][3] : 0.f);
          impb[(hh * 64 + qs * 32 + r) * 33 + kb * 8 + 2 * g8 + h] = part[kb][g8] + prev;
        }
      f32x16 oc[2];
#pragma unroll
      for (int db = 0; db < 2; ++db)
#pragma unroll
        for (int i = 0; i < 16; ++i) oc[db][i] = 0.f;
#pragma unroll
      for (int kb = 0; kb < 4; ++kb)
#pragma unroll
        for (int s2 = 0; s2 < 2; ++s2) {
          u32x4 pw;
#pragma unroll
          for (int jj = 0; jj < 4; ++jj) pw[jj] = pk2(s[kb][8 * s2 + 2 * jj], s[kb][8 * s2 + 2 * jj + 1]);
          const bf16x8 pf = __builtin_bit_cast(bf16x8, pw);
#pragma unroll
          for (int db = 0; db < 2; ++db) {
            const bf16x8 a = *(const bf16x8*)(sVt + (db * 32 + r) * 136 + kb * 32 + s2 * 16 + h * 8);
            oc[db] = mfma32(a, pf, oc[db]);
          }
        }
#pragma unroll
      for (int db = 0; db < 2; ++db)
#pragma unroll
        for (int i = 0; i < 16; ++i) tot[db][i] = oc[db][i] * g0;
    }
    __syncthreads();
    {
      const int rr = tid >> 3, t = qt * 64 + rr, cur = t >> 6;
#pragma unroll
      for (int jj = 0; jj < 4; ++jj) {
        const int j = (tid & 7) * 4 + jj;
        float v = (impb[(0 * 64 + rr) * 33 + j] + impb[(1 * 64 + rr) * 33 + j]) + (impb[(2 * 64 + rr) * 33 + j] + impb[(3 * 64 + rr) * 33 + j]);
        const bool forced = (j == 0) || (j == cur) || (j == cur - 1);
        const bool adm = j * 64 <= t;
        v = forced ? __builtin_huge_valf() : v;
        v = adm ? v : NEG_INF;
        imps[rr * 33 + j] = v;
      }
    }
    __syncthreads();
    {
      const int rr = tid >> 3;
      unsigned bits = 0;
#pragma unroll
      for (int jj = 0; jj < 4; ++jj) {
        const int j = (tid & 7) * 4 + jj;
        const float v = imps[rr * 33 + j];
        int cnt = 0;
#pragma unroll 8
        for (int j2 = 0; j2 < 32; ++j2) { const float v2 = imps[rr * 33 + j2]; cnt += ((v2 > v) || (v2 == v && j2 < j)) ? 1 : 0; }
        if (cnt < 16) bits |= 1u << j;
      }
      bits |= __shfl_xor((int)bits, 1); bits |= __shfl_xor((int)bits, 2); bits |= __shfl_xor((int)bits, 4);
      if ((tid & 7) == 0) selm[rr] = bits;
    }
    __syncthreads();
    const unsigned mysel = selm[qs * 32 + r];
    unsigned U = selm[r] | selm[32 + r];
#pragma unroll
    for (int off = 1; off < 32; off <<= 1) U |= (unsigned)__shfl_xor((int)U, off);
    const int jmax = qt;
    const unsigned causal = (jmax >= 31) ? 0xffffffffu : ((1u << (jmax + 1)) - 1u);
    U &= causal;
    U = (unsigned)__builtin_amdgcn_readfirstlane((int)U);
    nsa_branch<0>(tot, g1, U, qf, (bf16_t*)smem, (bf16_t*)(smem + 27648), yb, O_KS + g * 64, O_VS + g * 64, q0, tq, mysel);
    const int jlo = (qt * 64 >= 511 ? (qt * 64 - 511) : 0) >> 6;
    const unsigned W = causal & ~((1u << jlo) - 1u);
    nsa_branch<1>(tot, g2, W, qf, (bf16_t*)smem, (bf16_t*)(smem + 27648), yb, O_KW + g * 64, O_VW + g * 64, q0, tq, 0u);
    bf16_t* orow = p.O + tok * 1024 + head * 64;
#pragma unroll
    for (int db = 0; db < 2; ++db)
#pragma unroll
      for (int gg = 0; gg < 4; ++gg)
        store_bf4(orow + db * 32 + 8 * gg + 4 * h, (f32x4){tot[db][4 * gg], tot[db][4 * gg + 1], tot[db][4 * gg + 2], tot[db][4 * gg + 3]});
  }
}

#define XB_TMO      128
#define XB_XCNT(j)  (256  + 64 * (j))
#define XB_XSUB(j)  (1280 + 64 * (j))
#define XB_XGEN(j)  (2304 + 64 * (j))
#define XB_TOP      3328
#define XB_TOPGEN   3392
#define XCD_BAR_WORDS 3456
#define XB_SPIN_CAP (1u << 18)
#define XLAS __attribute__((address_space(3)))

__device__ __forceinline__ unsigned xb_ld(unsigned* p)              { return __hip_atomic_load(p, __ATOMIC_RELAXED, __HIP_MEMORY_SCOPE_AGENT); }
__device__ __forceinline__ unsigned xb_add(unsigned* p, unsigned v) { return __hip_atomic_fetch_add(p, v, __ATOMIC_RELAXED, __HIP_MEMORY_SCOPE_AGENT); }
__device__ __forceinline__ unsigned xb_xcc_id() { return (unsigned)__builtin_amdgcn_s_getreg((3 << 11) | 20) & 0xFu; }
#define XB_SPIN(cond, bar) do { unsigned _sp = 0; while (cond) { __builtin_amdgcn_s_sleep(1); \
    if ((++_sp & 255u) == 0u) { if (xb_ld(&(bar)[XB_TMO])) break; if (_sp > XB_SPIN_CAP) { atomicAdd(&(bar)[XB_TMO], 1u); break; } } } } while (0)

struct XcdBarrier {
    unsigned* bar; unsigned x;
    volatile XLAS unsigned* st;
};

__device__ __forceinline__ XcdBarrier xcd_barrier_post(unsigned* bar, volatile XLAS unsigned* st) {
    XcdBarrier b; b.bar = bar; b.x = xb_xcc_id(); b.st = st;
    if (threadIdx.x == 0) (void)xb_add(&bar[XB_XCNT(b.x)], 1u);
    return b;
}
__device__ __forceinline__ void xcd_barrier_complete(unsigned* bar, unsigned x, unsigned& nloc, unsigned& nx) {
    const unsigned G = gridDim.x * gridDim.y * gridDim.z;
    unsigned sum, cnt, mine, sp = 0u;
    for (;;) {
        sum = 0u; cnt = 0u; mine = 0u;
#pragma unroll
        for (unsigned j = 0; j < 16; ++j) { const unsigned c = xb_ld(&bar[XB_XCNT(j)]); sum += c; cnt += (c > 0u) ? 1u : 0u; mine = (j == x) ? c : mine; }
        if (sum == G) break;
        __builtin_amdgcn_s_sleep(1);
        if ((++sp & 255u) == 0u) { if (xb_ld(&bar[XB_TMO])) break; if (sp > XB_SPIN_CAP) { atomicAdd(&bar[XB_TMO], 1u); break; } }
    }
    nloc = mine > 0u ? mine : 1u; nx = cnt > 0u ? cnt : 1u;
}

__device__ __forceinline__ void xcd_barrier(const XcdBarrier& b) {
    asm volatile("s_waitcnt vmcnt(0)" ::: "memory");
    __syncthreads();
    if (threadIdx.x == 0) {
        unsigned* bar = b.bar;
        __builtin_amdgcn_s_waitcnt(0);
        unsigned nloc = b.st[0], nx = b.st[1];
        if (nloc == 0u) { xcd_barrier_complete(bar, b.x, nloc, nx); b.st[0] = nloc; b.st[1] = nx; }
        const unsigned old = xb_add(&bar[XB_XSUB(b.x)], 1u);
        const unsigned gen = old / nloc;
        if (old + 1u == (gen + 1u) * nloc) {
            __builtin_amdgcn_fence(__ATOMIC_RELEASE, "agent");
            asm volatile("s_waitcnt vmcnt(0)" ::: "memory");
            const unsigned og = xb_add(&bar[XB_TOP], 1u);
            const unsigned tg = og / nx;
            if (og + 1u == (tg + 1u) * nx) xb_add(&bar[XB_TOPGEN], 1u);
            else XB_SPIN(xb_ld(&bar[XB_TOPGEN]) == tg, bar);
            __builtin_amdgcn_fence(__ATOMIC_ACQUIRE, "agent");
            xb_add(&bar[XB_XGEN(b.x)], 1u);
            asm volatile("s_waitcnt vmcnt(0)" ::: "memory");
        } else {
            XB_SPIN(xb_ld(&bar[XB_XGEN(b.x)]) == gen, bar);
            __builtin_amdgcn_fence(__ATOMIC_ACQUIRE, "agent");
            asm volatile("s_waitcnt vmcnt(0)" ::: "memory");
        }
    }
    __syncthreads();
}


constexpr int LDS_BYTES = 131072 + 4096 + 16;
__global__ void __launch_bounds__(512, 2) fwd_kernel(Params p) {
  cg::grid_group grid = cg::this_grid();
  extern __shared__ __attribute__((aligned(16))) unsigned char lds[];
  char* smem = (char*)lds;
  float* red = (float*)(lds + 131072);
  volatile XLAS unsigned* xst = (volatile XLAS unsigned*)(lds + 131072 + 4096);
  if (threadIdx.x == 0) { xst[0] = 0u; xst[1] = 0u; }
  __syncthreads();
  const XcdBarrier xbar = xcd_barrier_post(p.BAR, xst);
  if (p.out == nullptr) grid.sync();
  for (int rep = 0; rep < REP_PRO; ++rep) { prologue(smem, p); rmsnorm_phase<true>(p, p.x, p.norm_mix, p.H, nullptr); xcd_barrier(xbar); }
  if (blockIdx.x < 4 && threadIdx.x < 128) { float s = 0.f; for (int i = 0; i < 64; ++i) s += p.CBP[(blockIdx.x * 64 + i) * 128 + threadIdx.x]; p.CB[blockIdx.x * 128 + threadIdx.x] = s; }
  for (int r4 = 0; r4 < 40; ++r4) xcd_barrier(xbar);
  const float* xcur = p.x;
  for (int layer = 0; layer < 4; ++layer) {
    const int j = layer >> 1;
    bool mixed = false;
    if ((layer & 1) == 0) {
#if EN_EVEN
      mixed = true;
      if (layer != 0) { rmsnorm_phase<true>(p, xcur, p.norm_mix + layer * DM, p.H, nullptr);
      xcd_barrier(xbar); }
      for (int rep = 0; rep < REP_GEMM; ++rep) { big_gemm(lds, p.H, p.WE + (long)j * LDE * DM, LDE, DM, EpiEven{p.Y, p.IW, p.ev_kv_gain + j * 128, p.cos64, p.sin64, p.cos32, p.sin32, red});
      xcd_barrier(xbar); }
      for (int rep = 0; rep < REP_ATT; ++rep) {
#if EN_DSA
      for (int r2 = 0; r2 < REP_IDX; ++r2) idx_phase(smem, p);
#endif
#if EN_DIFF
      for (int r2 = 0; r2 < REP_DIFF; ++r2) diff_phase(smem, p, j, layer == 0 ? 0.2f : 0.47071301834358416f);
#else
      for (long i = (long)blockIdx.x * NTHR + threadIdx.x; i < (long)NTOK * 512; i += (long)gridDim.x * NTHR) p.O[(i >> 9) * DM + 512 + (i & 511)] = 0;
#endif
      xcd_barrier(xbar);
#if EN_DSA
      dsa_phase(smem, p, j);
#else
      for (long i = (long)blockIdx.x * NTHR + threadIdx.x; i < (long)NTOK * 512; i += (long)gridDim.x * NTHR) p.O[(i >> 9) * DM + (i & 511)] = 0;
#endif
      xcd_barrier(xbar);
      }
      big_gemm(lds, p.O, p.WEO + (long)j * DM * DM, DM, DM, EpiResid{xcur, p.out});
      xcd_barrier(xbar);
#endif
    } else {
#if EN_ODD
      mixed = true;
      rmsnorm_phase<true>(p, xcur, p.norm_mix + layer * DM, p.H, nullptr);
      xcd_barrier(xbar);
      for (int rep = 0; rep < REP_GEMM; ++rep) { big_gemm(lds, p.H, p.WO + (long)j * NODD * DM, NODD, DM, EpiOdd{p.Y, p.GATES, p.cos64, p.sin64});
      xcd_barrier(xbar); }
      cmp_phase(smem, p, j);
      xcd_barrier(xbar);
      for (int rep = 0; rep < REP_ATT; ++rep) { nsa_phase(smem, p);
      xcd_barrier(xbar); }
      big_gemm(lds, p.O, p.WOO + (long)j * DM * DM, DM, DM, EpiResid{xcur, p.out});
      xcd_barrier(xbar);
#endif
    }
    if (!mixed && layer == 0) {
      for (long i = (long)blockIdx.x * NTHR + threadIdx.x; i < (long)NTOK * DM / 4; i += (long)gridDim.x * NTHR) ((f32x4*)p.out)[i] = ((const f32x4*)p.x)[i];
      xcd_barrier(xbar);
    }
    xcur = p.out;
#if EN_FFN
    rmsnorm_phase<true>(p, xcur, p.norm_ffn + layer * DM, p.H, nullptr);
    xcd_barrier(xbar);
    for (int rep = 0; rep < REP_GEMM; ++rep) { big_gemm(lds, p.H, p.WGU + (long)layer * 2 * DFF * DM, 2 * DFF, DM, EpiSwiglu{p.Y});
    xcd_barrier(xbar); }
    big_gemm(lds, p.Y, p.WD + (long)layer * DM * DFF, DM, DFF, EpiResid{p.out, p.out});
    xcd_barrier(xbar);
#endif
  }
  rmsnorm_phase<false>(p, p.out, p.norm_final, nullptr, p.out);
}

extern "C" void kernel_launch(void* const* d_in, const int* in_sizes, int n_in, void* d_out, int out_size, void* d_ws, size_t ws_size, hipStream_t stream) {
  static int grid_blocks = 0;
  if (!grid_blocks) {
    int dev = 0, cus = 0, per_cu = 0;
    (void)hipGetDevice(&dev);
    (void)hipDeviceGetAttribute(&cus, hipDeviceAttributeMultiprocessorCount, dev);
    if (hipFuncSetAttribute((const void*)fwd_kernel, hipFuncAttributeMaxDynamicSharedMemorySize, LDS_BYTES) != hipSuccess) fprintf(stderr, "hipFuncSetAttribute failed\n");
    (void)hipOccupancyMaxActiveBlocksPerMultiprocessor(&per_cu, fwd_kernel, NTHR, LDS_BYTES);
    if (per_cu < 1) fprintf(stderr, "occupancy query says %d blocks per CU\n", per_cu);
    (void)hipGetLastError();
    grid_blocks = cus;
    if (grid_blocks > 256) grid_blocks = 256;
  }
  Params p{};
  const float* const* in = (const float* const*)d_in;
  p.x = in[0]; p.norm_mix = in[1]; p.norm_ffn = in[2]; p.norm_final = in[3]; p.ev_w_in = in[4]; p.ev_kv_gain = in[5]; p.ev_w_uk = in[6]; p.ev_w_uv = in[7];
  p.ev_lambda = in[8]; p.ev_subln = in[9]; p.ev_w_out = in[10]; p.od_w_in = in[11]; p.od_cmp_pe = in[12]; p.od_cmp_w1 = in[13]; p.od_cmp_w2 = in[14];
  p.od_w_out = in[15]; p.ffn_w_gate = in[16]; p.ffn_w_up = in[17]; p.ffn_w_down = in[18];
  p.out = (float*)d_out;
  char* w = (char*)d_ws; size_t off = 0;
  auto take = [&](size_t bytes) { char* r = w + off; off += (bytes + 255) & ~(size_t)255; return r; };
  p.WE = (bf16_t*)take((size_t)2 * LDE * DM * 2);
  p.WEO = (bf16_t*)take((size_t)2 * DM * DM * 2);
  p.WUVP = (bf16_t*)take((size_t)2 * 8 * 64 * 128 * 2);
  p.WUKT = (bf16_t*)take((size_t)2 * 8 * 128 * 64 * 2);
  p.WO = (bf16_t*)take((size_t)2 * NODD * DM * 2);
  p.WOO = (bf16_t*)take((size_t)2 * DM * DM * 2);
  p.WGU = (bf16_t*)take((size_t)4 * 2 * DFF * DM * 2);
  p.WD = (bf16_t*)take((size_t)4 * DM * DFF * 2);
  p.WC1 = (bf16_t*)take((size_t)4 * 128 * 2048 * 2);
  p.WC2 = (bf16_t*)take((size_t)4 * 128 * 128 * 2);
  p.CBP = (float*)take((size_t)4 * 64 * 128 * 4);
  p.CB = (float*)take((size_t)4 * 128 * 4);
  p.cos64 = (float*)take((size_t)T * 32 * 4); p.sin64 = (float*)take((size_t)T * 32 * 4);
  p.cos32 = (float*)take((size_t)T * 16 * 4); p.sin32 = (float*)take((size_t)T * 16 * 4);
  p.H = (bf16_t*)take((size_t)NTOK * DM * 2);
  p.Y = (bf16_t*)take((size_t)(NTOK + 64) * LDE * 2);
  p.O = (bf16_t*)take((size_t)NTOK * DM * 2);
  p.SEL = (u64*)take((size_t)NTOK * 32 * 8);
  p.IW = (float*)take((size_t)NTOK * 8 * 4);
  p.GATES = (float*)take((size_t)NTOK * 48 * 4);
  p.BAR = (unsigned*)take((size_t)XCD_BAR_WORDS * 4);
  p.SCR = (float*)p.H;
  p.CH = p.H; p.KCMP = p.H + (size_t)2 * 8192 * 128; p.VCMP = p.KCMP + (size_t)8192 * 64;
  if (off > ws_size) fprintf(stderr, "workspace too small: need %zu have %zu\n", off, ws_size);
  if (hipMemsetAsync(p.BAR, 0, (size_t)XCD_BAR_WORDS * 4, stream) != hipSuccess) fprintf(stderr, "memset of barrier words failed\n");
  void* args[] = {&p};
  hipError_t e = hipLaunchCooperativeKernel((void*)fwd_kernel, dim3(grid_blocks), dim3(NTHR), args, LDS_BYTES, stream);
  if (e != hipSuccess) fprintf(stderr, "cooperative launch failed: %s (grid %d)\n", hipGetErrorString(e), grid_blocks);
}
```
